# Optimizing an MI355X kernel written in HIP

```python
import jax, jax.numpy as jnp
from jax import lax
import numpy as np

D_MODEL = 1024
BATCH = 16
SEQ = 2048
DEPTH = 2

N_META = 16
BLOCK = 128
N_PAD = BLOCK - N_META
NORM_EPS = 1e-6
NEG = -1e30

SB_HEADS = 8
SB_DIM = 64
SB_WIDTH = SB_HEADS * SB_DIM

MLA_HEADS = 8
MLA_Q_LORA = 256
MLA_KV_LORA = 128
MLA_NOPE = 64
MLA_ROPE = 32
MLA_V = 64
MLA_WIDTH = MLA_HEADS * MLA_V
ROPE_BASE = 10000.0

SWA_HEADS = 16
SWA_KV_HEADS = 2
SWA_DIM = 64
SWA_WINDOW = 128
SWA_WIDTH = SWA_HEADS * SWA_DIM

EVEN_SPLITS = [SB_WIDTH, SB_WIDTH, SB_WIDTH, SB_WIDTH,
               MLA_Q_LORA, MLA_KV_LORA, MLA_ROPE, MLA_WIDTH]
EVEN_IN = sum(EVEN_SPLITS)
EVEN_OUT = SB_WIDTH + MLA_WIDTH
ODD_SPLITS = [SWA_WIDTH, SWA_KV_HEADS * SWA_DIM, SWA_KV_HEADS * SWA_DIM, SWA_WIDTH]
ODD_IN = sum(ODD_SPLITS)
ODD_OUT = SWA_WIDTH

kernel_name = "hybrid_stickbreak_mla_swa_meta"


def _offsets(sizes):
    return [int(o) for o in np.cumsum(sizes)[:-1]]


def rmsnorm(x, g):
    xf = x.astype(jnp.float32)
    y = xf * lax.rsqrt(jnp.mean(xf * xf, axis=-1, keepdims=True) + NORM_EPS)
    return (y * g.astype(jnp.float32)).astype(x.dtype)


def apply_rope(x, pos):
    half = x.shape[-1] // 2
    inv = ROPE_BASE ** (-jnp.arange(half, dtype=jnp.float32) / half)
    ang = pos.astype(jnp.float32)[:, None] * inv[None, :]
    cos = jnp.cos(ang)[:, None, :]
    sin = jnp.sin(ang)[:, None, :]
    x1 = x[..., :half].astype(jnp.float32)
    x2 = x[..., half:].astype(jnp.float32)
    return jnp.concatenate([x1 * cos - x2 * sin, x1 * sin + x2 * cos], axis=-1).astype(x.dtype)


def alibi_slopes(n_heads):
    return 2.0 ** (-8.0 * (jnp.arange(n_heads, dtype=jnp.float32) + 1.0) / n_heads)


def stick_breaking_attention(q, k, v):
    Lp = q.shape[1]
    pos = jnp.arange(Lp)
    scale = SB_DIM ** -0.5
    outs = []
    for i in range(Lp // BLOCK):
        q0, q1 = i * BLOCK, (i + 1) * BLOCK
        z = jnp.einsum('bthd,bshd->bhts', q[:, q0:q1], k[:, :q1]).astype(jnp.float32) * scale
        t_pos = pos[q0:q1][:, None]
        s_pos = pos[:q1][None, :]
        mask = (s_pos < t_pos) & (s_pos >= N_PAD)
        log_beta = jax.nn.log_sigmoid(z)
        log_1m = jnp.where(mask, log_beta - z, 0.0)
        suffix = lax.cumsum(log_1m, axis=3, reverse=True) - log_1m
        a = jnp.where(mask, jnp.exp(log_beta + suffix), 0.0)
        outs.append(jnp.einsum('bhts,bshd->bthd', a.astype(v.dtype), v[:, :q1]))
    return jnp.concatenate(outs, axis=1)


def causal_block_softmax_attention(q, k, v, scale):
    Lp = q.shape[1]
    pos = jnp.arange(Lp)
    outs = []
    for i in range(Lp // BLOCK):
        q0, q1 = i * BLOCK, (i + 1) * BLOCK
        s = jnp.einsum('bthd,bshd->bhts', q[:, q0:q1], k[:, :q1]).astype(jnp.float32) * scale
        mask = (pos[None, :q1] <= pos[q0:q1, None]) & (pos[None, :q1] >= N_PAD)
        p = jax.nn.softmax(jnp.where(mask, s, NEG), axis=-1)
        outs.append(jnp.einsum('bhts,bshd->bthd', p.astype(v.dtype), v[:, :q1]))
    return jnp.concatenate(outs, axis=1)


def sliding_window_sink_attention(q, k, v, sinks):
    B, Lp = q.shape[0], q.shape[1]
    nb = Lp // BLOCK
    G = SWA_HEADS // SWA_KV_HEADS
    K = SWA_KV_HEADS
    qb = q.reshape(B, nb, BLOCK, K, G, SWA_DIM)
    kb = k.reshape(B, nb, BLOCK, K, SWA_DIM)
    vb = v.reshape(B, nb, BLOCK, K, SWA_DIM)
    shift = ((0, 0), (1, 0), (0, 0), (0, 0), (0, 0))
    k_band = jnp.concatenate([jnp.pad(kb[:, :-1], shift), kb], axis=2)
    v_band = jnp.concatenate([jnp.pad(vb[:, :-1], shift), vb], axis=2)
    k_meta = k[:, N_PAD:BLOCK]
    v_meta = v[:, N_PAD:BLOCK]
    blk = jnp.arange(nb)[:, None] * BLOCK
    t_pos = blk + jnp.arange(BLOCK)[None, :]
    s_pos = blk - BLOCK + jnp.arange(2 * BLOCK)[None, :]
    m_pos = N_PAD + jnp.arange(N_META)
    d_band = t_pos[:, :, None] - s_pos[:, None, :]
    d_meta = t_pos[:, :, None] - m_pos[None, None, :]
    band_ok = (d_band >= 0) & (d_band < SWA_WINDOW) & (s_pos[:, None, :] >= BLOCK)
    meta_ok = d_meta >= 0
    slopes = alibi_slopes(SWA_HEADS).reshape(K, G)[:, :, None, None]
    scale = SWA_DIM ** -0.5
    s_band = (jnp.einsum('bnqkgd,bnskd->bnkgqs', qb, k_band).astype(jnp.float32) * scale
              - slopes * d_band.astype(jnp.float32)[:, None, None])
    s_band = jnp.where(band_ok[:, None, None], s_band, NEG)
    s_meta = (jnp.einsum('bnqkgd,bmkd->bnkgqm', qb, k_meta).astype(jnp.float32) * scale
              - slopes * d_meta.astype(jnp.float32)[:, None, None])
    s_meta = jnp.where(meta_ok[:, None, None], s_meta, NEG)
    sink = jnp.broadcast_to(sinks.astype(jnp.float32).reshape(K, G, 1, 1),
                            s_band.shape[:-1] + (1,))
    p = jax.nn.softmax(jnp.concatenate([s_band, s_meta, sink], axis=-1), axis=-1)
    S = 2 * BLOCK
    p_band = p[..., :S].astype(v.dtype)
    p_meta = p[..., S:S + N_META].astype(v.dtype)
    o = (jnp.einsum('bnkgqs,bnskd->bnqkgd', p_band, v_band)
         + jnp.einsum('bnkgqm,bmkd->bnqkgd', p_meta, v_meta))
    return o.reshape(B, Lp, SWA_WIDTH)


def even_layer(h, pos, w_in, q_norm_g, kv_norm_g, w_uq, w_ukv, w_out):
    B, Lp = h.shape[0], h.shape[1]
    proj = h @ w_in
    q_sb, k_sb, v_sb, g_sb, c_q, c_kv, k_r, g_mla = jnp.split(proj, _offsets(EVEN_SPLITS), axis=-1)
    shp = (B, Lp, SB_HEADS, SB_DIM)
    o_sb = stick_breaking_attention(q_sb.reshape(shp), k_sb.reshape(shp), v_sb.reshape(shp))
    o_sb = o_sb.reshape(B, Lp, SB_WIDTH) * jax.nn.silu(g_sb)
    qh = (rmsnorm(c_q, q_norm_g) @ w_uq).reshape(B, Lp, MLA_HEADS, MLA_NOPE + MLA_ROPE)
    q_nope, q_rope = qh[..., :MLA_NOPE], qh[..., MLA_NOPE:]
    kvh = (rmsnorm(c_kv, kv_norm_g) @ w_ukv).reshape(B, Lp, MLA_HEADS, MLA_NOPE + MLA_V)
    k_nope, v_mla = kvh[..., :MLA_NOPE], kvh[..., MLA_NOPE:]
    k_rope = apply_rope(k_r[:, :, None, :], pos)
    q_full = jnp.concatenate([q_nope, apply_rope(q_rope, pos)], axis=-1)
    k_full = jnp.concatenate(
        [k_nope, jnp.broadcast_to(k_rope, (B, Lp, MLA_HEADS, MLA_ROPE))], axis=-1)
    o_mla = causal_block_softmax_attention(q_full, k_full, v_mla, (MLA_NOPE + MLA_ROPE) ** -0.5)
    o_mla = o_mla.reshape(B, Lp, MLA_WIDTH) * jax.nn.silu(g_mla)
    return jnp.concatenate([o_sb, o_mla], axis=-1) @ w_out


def odd_layer(h, w_in, sinks, w_out):
    B, Lp = h.shape[0], h.shape[1]
    proj = h @ w_in
    q, k, v, g = jnp.split(proj, _offsets(ODD_SPLITS), axis=-1)
    o = sliding_window_sink_attention(
        q.reshape(B, Lp, SWA_HEADS, SWA_DIM),
        k.reshape(B, Lp, SWA_KV_HEADS, SWA_DIM),
        v.reshape(B, Lp, SWA_KV_HEADS, SWA_DIM), sinks)
    return (o * jax.nn.silu(g)) @ w_out


def setup_inputs(seed: int = 0) -> dict:
    key = jax.random.key(seed)
    ks = jax.random.split(key, 13)
    ne = (DEPTH + 1) // 2
    no = DEPTH // 2
    f32 = jnp.float32

    def w(k, shape, fan_in):
        return jax.random.normal(k, shape, f32) * (fan_in ** -0.5)

    def gain(k, shape):
        return 1.0 + 0.05 * jax.random.normal(k, shape, f32)

    return {
        "x": jax.random.normal(ks[0], (BATCH, SEQ, D_MODEL), f32),
        "meta": jax.random.normal(ks[1], (N_META, D_MODEL), f32),
        "norm_g": gain(ks[2], (DEPTH, D_MODEL)),
        "final_g": gain(ks[3], (D_MODEL,)),
        "ev_w_in": w(ks[4], (ne, D_MODEL, EVEN_IN), D_MODEL),
        "ev_q_norm_g": gain(ks[5], (ne, MLA_Q_LORA)),
        "ev_kv_norm_g": gain(ks[6], (ne, MLA_KV_LORA)),
        "ev_w_uq": w(ks[7], (ne, MLA_Q_LORA, MLA_HEADS * (MLA_NOPE + MLA_ROPE)), MLA_Q_LORA),
        "ev_w_ukv": w(ks[8], (ne, MLA_KV_LORA, MLA_HEADS * (MLA_NOPE + MLA_V)), MLA_KV_LORA),
        "ev_w_out": w(ks[9], (ne, EVEN_OUT, D_MODEL), EVEN_OUT),
        "od_w_in": w(ks[10], (no, D_MODEL, ODD_IN), D_MODEL),
        "od_sinks": 0.5 * jax.random.normal(ks[11], (no, SWA_HEADS), f32),
        "od_w_out": w(ks[12], (no, ODD_OUT, D_MODEL), ODD_OUT),
    }


def reference(x, meta, norm_g, final_g, ev_w_in, ev_q_norm_g, ev_kv_norm_g, ev_w_uq,
              ev_w_ukv, ev_w_out, od_w_in, od_sinks, od_w_out):
    B = x.shape[0]
    meta_b = jnp.broadcast_to(meta.astype(x.dtype)[None], (B, N_META, D_MODEL))
    pad = jnp.zeros((B, N_PAD, D_MODEL), x.dtype)
    h = jnp.concatenate([pad, meta_b, x], axis=1)
    pos = jnp.arange(h.shape[1]) - N_PAD
    for layer in range(DEPTH):
        hn = rmsnorm(h, norm_g[layer])
        if layer % 2 == 0:
            i = layer // 2
            h = h + even_layer(hn, pos, ev_w_in[i], ev_q_norm_g[i], ev_kv_norm_g[i],
                               ev_w_uq[i], ev_w_ukv[i], ev_w_out[i])
        else:
            i = layer // 2
            h = h + odd_layer(hn, od_w_in[i], od_sinks[i], od_w_out[i])
    return rmsnorm(h, final_g)[:, BLOCK:]
```

```cpp
#include <hip/hip_runtime.h>
#include <hip/hip_cooperative_groups.h>
#include <cstdio>
namespace cg = cooperative_groups;

#define DI __device__ __forceinline__
#define LAS __attribute__((address_space(3)))
typedef unsigned short bf16_t;
typedef short bf16x8 __attribute__((ext_vector_type(8)));
typedef short s16x4 __attribute__((ext_vector_type(4)));
typedef float f32x4 __attribute__((ext_vector_type(4)));
typedef float f32x16 __attribute__((ext_vector_type(16)));
typedef float f32x2_t __attribute__((ext_vector_type(2)));
typedef __bf16 bf16x2_t __attribute__((ext_vector_type(2)));
typedef unsigned u32x4 __attribute__((ext_vector_type(4)));
typedef unsigned u32x2 __attribute__((ext_vector_type(2)));

#ifndef COOP
#define COOP 1
#endif

constexpr int NBATCH = 16, SEQ = 2048, DM = 1024, R = NBATCH * SEQ, NMETA = 16;
constexpr float EPS = 1e-6f;
constexpr float LOG2E = 1.4426950408889634f;
constexpr int LDS_BYTES = 131072 + 256;
constexpr float QS64 = 0.125f * LOG2E, QS96 = 0.10206207261596575f * LOG2E;
constexpr float SB_THRESH = -152.f;

constexpr size_t OFF_WT_IN0 = 0;
constexpr size_t OFF_WT_UQ = OFF_WT_IN0 + (size_t)3072 * 1024 * 2;
constexpr size_t OFF_WT_UK = OFF_WT_UQ + (size_t)768 * 256 * 2;
constexpr size_t OFF_WT_UV = OFF_WT_UK + (size_t)512 * 256 * 2;
constexpr size_t OFF_WT_OUT0 = OFF_WT_UV + (size_t)512 * 256 * 2;
constexpr size_t OFF_WT_IN1 = OFF_WT_OUT0 + (size_t)1024 * 1024 * 2;
constexpr size_t OFF_WT_OUT1 = OFF_WT_IN1 + (size_t)2304 * 1024 * 2;
constexpr size_t OFF_HN = OFF_WT_OUT1 + (size_t)1024 * 1024 * 2;
constexpr size_t OFF_PROJ = OFF_HN + (size_t)R * 1024 * 2;
constexpr size_t OFF_VSBT = OFF_PROJ + (size_t)R * 3072 * 2;
constexpr size_t OFF_QM = OFF_VSBT + (size_t)512 * R * 2;
constexpr size_t OFF_KM = OFF_QM + (size_t)R * 768 * 2;
constexpr size_t OFF_VMT = OFF_KM + (size_t)R * 512 * 2;
constexpr size_t OFF_SSQ_Q = OFF_VMT + (size_t)512 * R * 2;
constexpr size_t OFF_SSQ_KV = OFF_SSQ_Q + (size_t)R * 4;
constexpr size_t OFF_COS = OFF_SSQ_KV + (size_t)R * 4;
constexpr size_t OFF_SIN = OFF_COS + (size_t)2064 * 16 * 4;
constexpr size_t OFF_HN_META = OFF_SIN + (size_t)2064 * 16 * 4;
constexpr size_t OFF_AO_META = OFF_HN_META + (size_t)16 * 1024 * 2;
constexpr size_t OFF_PROJ_META = OFF_AO_META + (size_t)16 * 1024 * 2;
constexpr size_t OFF_VSBT_META = OFF_PROJ_META + (size_t)16 * 3072 * 2;
constexpr size_t OFF_QM_META = OFF_VSBT_META + (size_t)512 * 16 * 2;
constexpr size_t OFF_KM_META = OFF_QM_META + (size_t)16 * 768 * 2;
constexpr size_t OFF_VMT_META = OFF_KM_META + (size_t)16 * 512 * 2;
constexpr size_t OFF_H1_META = OFF_VMT_META + (size_t)512 * 16 * 2;
constexpr size_t OFF_D1 = OFF_KM;
constexpr size_t OFF_D2 = OFF_PROJ;
constexpr size_t OFF_BAR = OFF_H1_META + (size_t)16 * 1024 * 4;
constexpr size_t BAR_BYTES = 16384;
constexpr size_t WS_END = OFF_BAR + BAR_BYTES;

struct Params {
    const float *x, *meta, *norm_g, *final_g, *ev_w_in, *ev_qg, *ev_kvg, *ev_w_uq, *ev_w_ukv, *ev_w_out, *od_w_in, *od_sinks, *od_w_out;
    float* out;
    unsigned char* ws;
    int ph_lo, ph_hi;
};

DI unsigned pk2(float a, float b) { f32x2_t v = {a, b}; return __builtin_bit_cast(unsigned, __builtin_convertvector(v, bf16x2_t)); }
DI float bflo(unsigned u) { return __uint_as_float(u << 16); }
DI float bfhi(unsigned u) { return __uint_as_float(u & 0xffff0000u); }
DI void st8(bf16_t* ptr, f32x4 a, f32x4 b) { u32x4 o; o.x = pk2(a[0], a[1]); o.y = pk2(a[2], a[3]); o.z = pk2(b[0], b[1]); o.w = pk2(b[2], b[3]); *(u32x4*)ptr = o; }
DI void st8_nt(bf16_t* ptr, f32x4 a, f32x4 b) { u32x4 o; o.x = pk2(a[0], a[1]); o.y = pk2(a[2], a[3]); o.z = pk2(b[0], b[1]); o.w = pk2(b[2], b[3]); __builtin_nontemporal_store(o, (u32x4*)ptr); }
DI void st4_nt(bf16_t* ptr, f32x4 v) { u32x2 o; o.x = pk2(v[0], v[1]); o.y = pk2(v[2], v[3]); __builtin_nontemporal_store(o, (u32x2*)ptr); }
DI void st4(bf16_t* ptr, f32x4 v) { u32x2 o; o.x = pk2(v[0], v[1]); o.y = pk2(v[2], v[3]); *(u32x2*)ptr = o; }
DI float wave_sum(float s) {
#pragma unroll
    for (int o = 32; o >= 1; o >>= 1) s += __shfl_xor(s, o);
    return s;
}
DI float xor32(float x, int hf) {
    const unsigned xi = __float_as_uint(x); auto r = __builtin_amdgcn_permlane32_swap(xi, xi, false, false);
    return __uint_as_float(hf ? r[0] : r[1]);
}
DI float fexp2(float x) { return __builtin_amdgcn_exp2f(x); }
DI float flog2(float x) { return __builtin_amdgcn_logf(x); }

constexpr int BM = 256, BK = 64, HALF = 128, HTB = HALF * BK * 2, NXCD = 8, WGM = 8;
DI int lds_byte(int r, int c) { const int st = (r >> 4) * 2 + (c >> 5), rr = r & 15, cc = c & 31, ob = rr * 64 + cc * 2; return st * 1024 + (ob ^ (((ob >> 9) & 1) << 5)); }
DI void stage_rc(int b, int& Rr, int& Cc) { const int st = b / 1024, sb = b % 1024, swz = sb ^ (((sb >> 9) & 1) << 5); Rr = (st >> 1) * 16 + swz / 64; Cc = (st & 1) * 32 + (swz % 64) / 2; }

struct GUnit { const unsigned char* A; const unsigned char* B; int lda, ldb; int kind, row0, col0, perm; };
DI int perm32(int rho) { const int n = rho >> 4, i = rho & 15; return 8 * (i >> 2) + 4 * n + (i & 3); }

DI bool order_unit(int i, int nM, int nN, int& pm, int& pn) {
    const int nwg = nM * nN; const long L = (long)i * gridDim.x + blockIdx.x; if (L >= nwg) return false;
    int wgid = (int)L; { const int q = nwg / NXCD, r = nwg % NXCD, xcd = wgid % NXCD, off = wgid / NXCD; wgid = (xcd < r ? xcd * (q + 1) : r * (q + 1) + (xcd - r) * q) + off; }
    const int nig = WGM * nN, gid = wgid / nig, fm = gid * WGM, gsz = (nM - fm) < WGM ? (nM - fm) : WGM;
    pm = fm + ((wgid % nig) % gsz); pn = (wgid % nig) / gsz; return true;
}

template <int PH> struct PhCfg;
template <> struct PhCfg<1> { static constexpr int K = 1024, nM = 128, nN = 12; };
template <> struct PhCfg<2> { static constexpr int K = 256, nM = 128, nN = 7; };
template <> struct PhCfg<4> { static constexpr int K = 1024, nM = 128, nN = 4; };
template <> struct PhCfg<6> { static constexpr int K = 1024, nM = 128, nN = 10; };
template <> struct PhCfg<8> { static constexpr int K = 1024, nM = 128, nN = 4; };

template <int PH> DI bool get_unit(const Params& p, int i, GUnit& u) {
    int pm, pn; if (!order_unit(i, PhCfg<PH>::nM, PhCfg<PH>::nN, pm, pn)) return false;
    const unsigned char* ws = p.ws;
    if (PH == 1) {
        if (pn >= 6 && pn <= 9) pn = (pn < 8) ? pn + 2 : pn - 2;
        const unsigned char* a = ws + OFF_HN + (size_t)pm * 256 * 2048; const unsigned char* b = ws + OFF_WT_IN0 + (size_t)pn * 256 * 2048;
        u.lda = 2048; u.ldb = 2048;
        if (pn == 4 || pn == 5) { u.A = b; u.B = a; u.kind = 1; u.row0 = (pn - 4) * 256; u.col0 = pm * 256; }
        else { u.A = a; u.B = b; u.kind = 0; u.row0 = pm * 256; u.col0 = pn * 256; }
        u.perm = 1;
    } else if (PH == 2) {
        if (pn < 3) { u.A = ws + OFF_PROJ + ((size_t)pm * 256 * 3072 + 2048) * 2; u.lda = 6144; u.B = ws + OFF_WT_UQ + (size_t)pn * 256 * 512; u.ldb = 512; u.kind = 0; u.row0 = pm * 256; u.col0 = pn * 256; }
        else if (pn < 5) { u.A = ws + OFF_PROJ + ((size_t)pm * 256 * 3072 + 2304) * 2; u.lda = 6144; u.B = ws + OFF_WT_UK + (size_t)(pn - 3) * 256 * 512; u.ldb = 512; u.kind = 1; u.row0 = pm * 256; u.col0 = (pn - 3) * 256; }
        else { u.B = ws + OFF_PROJ + ((size_t)pm * 256 * 3072 + 2304) * 2; u.ldb = 6144; u.A = ws + OFF_WT_UV + (size_t)(pn - 5) * 256 * 512; u.lda = 512; u.kind = 2; u.row0 = (pn - 5) * 256; u.col0 = pm * 256; }
        u.perm = 1;
    } else if (PH == 4 || PH == 8) {
        u.A = ws + OFF_HN + (size_t)pm * 256 * 2048; u.B = ws + (PH == 4 ? OFF_WT_OUT0 : OFF_WT_OUT1) + (size_t)pn * 256 * 2048; u.lda = 2048; u.ldb = 2048; u.kind = 0; u.row0 = pm * 256; u.col0 = pn * 256; u.perm = 1;
    } else {
        const unsigned char* a = ws + OFF_HN + (size_t)pm * 256 * 2048;
        u.lda = 2048; u.ldb = 2048;
        if (pn == 9) { u.A = ws + OFF_WT_IN1 + (size_t)4 * 256 * 2048; u.B = a; u.kind = 1; u.row0 = 0; u.col0 = pm * 256; }
        else { u.A = a; u.B = ws + OFF_WT_IN1 + (size_t)pn * 256 * 2048; u.kind = 0; u.row0 = pm * 256; u.col0 = pn * 256; }
        u.perm = 1;
    }
    return true;
}

DI void rope_perm(f32x4& v0, f32x4& v1, const float* cs, const float* sn, int fq) {
    const int hi = fq >> 1, jb = 8 * (fq & 1);
    const f32x4 c0 = *(const f32x4*)(cs + jb), c1 = *(const f32x4*)(cs + jb + 4);
    f32x4 s0 = *(const f32x4*)(sn + jb), s1 = *(const f32x4*)(sn + jb + 4);
    if (!hi) { s0 = -s0; s1 = -s1; }
    f32x4 o0, o1;
#pragma unroll
    for (int e = 0; e < 4; ++e) { o0[e] = xor32(v0[e], hi); o1[e] = xor32(v1[e], hi); }
    v0 = v0 * c0 + o0 * s0; v1 = v1 * c1 + o1 * s1;
}
template <int PH> DI void gemm_epi(const Params& p, const f32x4 (&acc)[2][2][4][2], const GUnit& u, int wr, int wc, int fr, int fq) {
    unsigned char* ws = p.ws;
    const int rbase = u.row0 + 64 * wr + fr, cbase = u.col0 + 32 * wc + (u.perm ? 8 : 4) * fq;
#define ST_PAIR(rowptr, bj, v0, v1) do { if (u.perm) st8_nt((rowptr) + cbase + 128 * (bj), v0, v1); else { st4_nt((rowptr) + cbase + 128 * (bj), v0); st4_nt((rowptr) + cbase + 128 * (bj) + 16, v1); } } while (0)
    if (PH == 1) {
        if (u.kind == 1) {
            bf16_t* vt = (bf16_t*)(ws + OFF_VSBT);
#pragma unroll
            for (int ai = 0; ai < 2; ++ai)
#pragma unroll
                for (int m = 0; m < 4; ++m) { const int row = rbase + 128 * ai + 16 * m;
#pragma unroll
                    for (int bj = 0; bj < 2; ++bj) ST_PAIR(vt + (size_t)row * R, bj, acc[ai][bj][m][0], acc[ai][bj][m][1]); }
            return;
        }
        bf16_t* proj = (bf16_t*)(ws + OFF_PROJ);
        const float* cosT = (const float*)(ws + OFF_COS); const float* sinT = (const float*)(ws + OFF_SIN);
        const float qscale = (u.col0 < 512) ? QS64 : 1.f;
        const bool do_rope = (u.col0 == 2304) && (wc == 0);
#pragma unroll
        for (int ai = 0; ai < 2; ++ai)
#pragma unroll
            for (int m = 0; m < 4; ++m) {
                const int row = rbase + 128 * ai + 16 * m;
                f32x4 v[2][2];
#pragma unroll
                for (int bj = 0; bj < 2; ++bj)
#pragma unroll
                    for (int n = 0; n < 2; ++n) v[bj][n] = acc[ai][bj][m][n] * qscale;
                if (u.col0 == 2048) {
                    float s = 0.f;
#pragma unroll
                    for (int bj = 0; bj < 2; ++bj)
#pragma unroll
                        for (int n = 0; n < 2; ++n)
#pragma unroll
                            for (int e = 0; e < 4; ++e) s += v[bj][n][e] * v[bj][n][e];
                    s += __shfl_xor(s, 16); s += __shfl_xor(s, 32);
                    if (fq == 0) atomicAdd((float*)(ws + OFF_SSQ_Q) + row, s);
                }
                if (u.col0 == 2304) {
                    float s = 0.f;
#pragma unroll
                    for (int n = 0; n < 2; ++n)
#pragma unroll
                        for (int e = 0; e < 4; ++e) s += v[0][n][e] * v[0][n][e];
                    s += __shfl_xor(s, 16); s += __shfl_xor(s, 32);
                    if (fq == 0) atomicAdd((float*)(ws + OFF_SSQ_KV) + row, s);
                    if (do_rope) {
                        const int pos = 16 + (row & (SEQ - 1));
                        rope_perm(v[1][0], v[1][1], cosT + pos * 16, sinT + pos * 16, fq);
                    }
                }
#pragma unroll
                for (int bj = 0; bj < 2; ++bj) ST_PAIR(proj + (size_t)row * 3072, bj, v[bj][0], v[bj][1]);
            }
    } else if (PH == 2) {
        if (u.kind == 2) {
            bf16_t* vt = (bf16_t*)(ws + OFF_VMT); const float* ssq = (const float*)(ws + OFF_SSQ_KV);
            f32x4 rs[2][2];
#pragma unroll
            for (int bj = 0; bj < 2; ++bj)
#pragma unroll
                for (int n = 0; n < 2; ++n) { const f32x4 q = *(const f32x4*)(ssq + cbase + 128 * bj + (u.perm ? 4 : 16) * n);
#pragma unroll
                    for (int e = 0; e < 4; ++e) rs[bj][n][e] = rsqrtf(q[e] * (1.f / 128.f) + EPS); }
#pragma unroll
            for (int ai = 0; ai < 2; ++ai)
#pragma unroll
                for (int m = 0; m < 4; ++m) { const int row = rbase + 128 * ai + 16 * m;
#pragma unroll
                    for (int bj = 0; bj < 2; ++bj) ST_PAIR(vt + (size_t)row * R, bj, acc[ai][bj][m][0] * rs[bj][0], acc[ai][bj][m][1] * rs[bj][1]); }
            return;
        }
        const float* cosT = (const float*)(ws + OFF_COS); const float* sinT = (const float*)(ws + OFF_SIN);
        float rsv[2][4];
        { const float* ssq = (const float*)(ws + (u.kind == 0 ? OFF_SSQ_Q : OFF_SSQ_KV)); const float dinv = (u.kind == 0) ? (1.f / 256.f) : (1.f / 128.f), mul = (u.kind == 0) ? QS96 : 1.f;
          float raw[2][4];
#pragma unroll
          for (int ai = 0; ai < 2; ++ai)
#pragma unroll
              for (int m = 0; m < 4; ++m) raw[ai][m] = ssq[rbase + 128 * ai + 16 * m];
#pragma unroll
          for (int ai = 0; ai < 2; ++ai)
#pragma unroll
              for (int m = 0; m < 4; ++m) rsv[ai][m] = rsqrtf(raw[ai][m] * dinv + EPS) * mul; }
        if (u.kind == 0) {
            bf16_t* qm = (bf16_t*)(ws + OFF_QM);
            const bool rope0 = (((u.col0 >> 5) + wc) % 3 == 2), rope1 = (((u.col0 >> 5) + 4 + wc) % 3 == 2);
#pragma unroll
            for (int ai = 0; ai < 2; ++ai)
#pragma unroll
                for (int m = 0; m < 4; ++m) {
                    const int row = rbase + 128 * ai + 16 * m; const float rs = rsv[ai][m]; const int pos = 16 + (row & (SEQ - 1));
#pragma unroll
                    for (int bj = 0; bj < 2; ++bj) {
                        f32x4 v0 = acc[ai][bj][m][0] * rs, v1 = acc[ai][bj][m][1] * rs;
                        if (bj == 0 ? rope0 : rope1) rope_perm(v0, v1, cosT + pos * 16, sinT + pos * 16, fq);
                        ST_PAIR(qm + (size_t)row * 768, bj, v0, v1);
                    }
                }
        } else {
            bf16_t* km = (bf16_t*)(ws + OFF_KM);
#pragma unroll
            for (int ai = 0; ai < 2; ++ai)
#pragma unroll
                for (int m = 0; m < 4; ++m) { const int row = rbase + 128 * ai + 16 * m; const float rs = rsv[ai][m];
#pragma unroll
                    for (int bj = 0; bj < 2; ++bj) ST_PAIR(km + (size_t)row * 512, bj, acc[ai][bj][m][0] * rs, acc[ai][bj][m][1] * rs); }
        }
    } else if (PH == 4 || PH == 8) {
        bf16_t* dst = (bf16_t*)(ws + (PH == 4 ? OFF_D1 : OFF_D2));
#pragma unroll
        for (int ai = 0; ai < 2; ++ai)
#pragma unroll
            for (int m = 0; m < 4; ++m) { const int row = rbase + 128 * ai + 16 * m;
#pragma unroll
                for (int bj = 0; bj < 2; ++bj) ST_PAIR(dst + (size_t)row * 1024, bj, acc[ai][bj][m][0], acc[ai][bj][m][1]); }
    } else {
        bf16_t* dst = (bf16_t*)(ws + (u.kind == 1 ? OFF_VSBT : OFF_PROJ)); const size_t ld = (u.kind == 1) ? (size_t)R : (size_t)2304;
        const float qscale = (u.kind == 0 && u.col0 < 1024) ? QS64 : 1.f;
#pragma unroll
        for (int ai = 0; ai < 2; ++ai)
#pragma unroll
            for (int m = 0; m < 4; ++m) { const int row = rbase + 128 * ai + 16 * m;
#pragma unroll
                for (int bj = 0; bj < 2; ++bj) ST_PAIR(dst + (size_t)row * ld, bj, acc[ai][bj][m][0] * qscale, acc[ai][bj][m][1] * qscale); }
    }
#undef ST_PAIR
}

template <int PH>
DI void gemm_phase(const Params& p, LAS unsigned char* lds) {
    constexpr int K = PhCfg<PH>::K, nt = K / BK;
    const int tid = threadIdx.x, wid = __builtin_amdgcn_readfirstlane(tid >> 6), lane = tid & 63, wr = wid >> 2, wc = wid & 3, fr = lane & 15, fq = lane >> 4;
    int Rr[2], Rp[2], Cc2[2];
#pragma unroll
    for (int i = 0; i < 2; ++i) { int a, b; stage_rc(tid * 16 + i * 8192, a, b); Rr[i] = a; Rp[i] = (a & ~31) + perm32(a & 31); Cc2[i] = b * 2; }
    const size_t kstep = (size_t)(BK * 2);
    const unsigned ldsw = (unsigned)wid * 1024u;
    const int aoff = lds_byte(wr * 64 + fr, fq * 8), boff = lds_byte(wc * 32 + fr, fq * 8);
#define G_SA(b, h) (((b) * 2 + (h)) * HTB)
#define G_SB(b, h) ((4 + (b) * 2 + (h)) * HTB)
#define G_STAGEB(bufoff, gbase, ld, pf) do { _Pragma("unroll") for (int _i = 0; _i < 2; ++_i) \
        __builtin_amdgcn_global_load_lds((const unsigned*)((gbase) + (size_t)(((pf) ? Rp[_i] : Rr[_i]) * (ld) + Cc2[_i])), (LAS unsigned*)(lds + (bufoff) + ldsw + _i * 8192), 16, 0, 0); } while (0)
#define G_STAGE(bufoff, gbase, ld) do { _Pragma("unroll") for (int _i = 0; _i < 2; ++_i) \
        __builtin_amdgcn_global_load_lds((const unsigned*)((gbase) + (size_t)(Rr[_i] * (ld) + Cc2[_i])), (LAS unsigned*)(lds + (bufoff) + ldsw + _i * 8192), 16, 0, 0); } while (0)
#define G_LDA(dst, b, h) do { _Pragma("unroll") for (int m = 0; m < 4; ++m) _Pragma("unroll") for (int k = 0; k < 2; ++k) dst[m][k] = *(const LAS bf16x8*)(lds + G_SA(b, h) + aoff + m * 2048 + k * 1024); } while (0)
#define G_LDB(dst, b, h) do { _Pragma("unroll") for (int n = 0; n < 2; ++n) _Pragma("unroll") for (int k = 0; k < 2; ++k) dst[n][k] = *(const LAS bf16x8*)(lds + G_SB(b, h) + boff + n * 2048 + k * 1024); } while (0)
#define G_MMA(ai, bj, At, Bt) do { __builtin_amdgcn_s_setprio(1); _Pragma("unroll") for (int m = 0; m < 4; ++m) _Pragma("unroll") for (int n = 0; n < 2; ++n) _Pragma("unroll") for (int k = 0; k < 2; ++k) \
        acc[ai][bj][m][n] = __builtin_amdgcn_mfma_f32_16x16x32_bf16(Bt[n][k], At[m][k], acc[ai][bj][m][n], 0, 0, 0); __builtin_amdgcn_s_setprio(0); } while (0)
#define G_WAIT_V(n) asm volatile("s_waitcnt vmcnt(" #n ")" ::: "memory")
#define G_WAIT_L(n) asm volatile("s_waitcnt lgkmcnt(" #n ")" ::: "memory")
#define G_BAR __builtin_amdgcn_s_barrier()
#define G_SCHED __builtin_amdgcn_sched_barrier(0)
    GUnit cur, nxt; int ui = 0;
    if (!get_unit<PH>(p, 0, cur)) return;
    f32x4 acc[2][2][4][2];
#pragma unroll
    for (int a = 0; a < 2; ++a)
#pragma unroll
        for (int b = 0; b < 2; ++b)
#pragma unroll
            for (int m = 0; m < 4; ++m)
#pragma unroll
                for (int n = 0; n < 2; ++n) acc[a][b][m][n] = (f32x4){0.f, 0.f, 0.f, 0.f};
    bf16x8 At[4][2], B0[2][2], B1[2][2];
    const unsigned char* cA = cur.A; const unsigned char* cB = cur.B; int lda = cur.lda, ldb = cur.ldb; int pfc = cur.perm;
    {
        const size_t hA = (size_t)HALF * lda, hB = (size_t)HALF * ldb;
        G_STAGEB(G_SB(0, 0), cB, ldb, pfc); G_STAGE(G_SA(0, 0), cA, lda); G_STAGEB(G_SB(0, 1), cB + hB, ldb, pfc); G_STAGE(G_SA(0, 1), cA + hA, lda);
        if (wr == 1) G_BAR;
        G_WAIT_V(4); G_BAR;
        G_STAGEB(G_SB(1, 0), cB + kstep, ldb, pfc); G_STAGE(G_SA(1, 0), cA + kstep, lda); G_STAGEB(G_SB(1, 1), cB + hB + kstep, ldb, pfc);
        G_WAIT_V(6); G_BAR;
    }
    for (;;) {
        const bool has_next = get_unit<PH>(p, ui + 1, nxt);
        const unsigned char* nA = has_next ? nxt.A : cA; const unsigned char* nB = has_next ? nxt.B : cB;
        const int nlda = has_next ? nxt.lda : lda, nldb = has_next ? nxt.ldb : ldb, npf = has_next ? nxt.perm : pfc;
        _Pragma("unroll 1") for (int t = 0; t < nt; t += 2) {
            const bool last = (t == nt - 2);
            const unsigned char* a1 = cA + (size_t)(t + 1) * kstep;
            const unsigned char* a2 = last ? nA : cA + (size_t)(t + 2) * kstep; const unsigned char* b2 = last ? nB : cB + (size_t)(t + 2) * kstep;
            const int lda2 = last ? nlda : lda, ldb2 = last ? nldb : ldb, pf2 = last ? npf : pfc;
            const size_t hA1 = (size_t)HALF * lda, hA2 = (size_t)HALF * lda2, hB2 = (size_t)HALF * ldb2;
            const unsigned char* a3 = a2 + kstep; const unsigned char* b3 = b2 + kstep;
            G_LDB(B0, 0, 0); G_SCHED; G_LDA(At, 0, 0); G_STAGE(G_SA(1, 1), a1 + hA1, lda);
            G_WAIT_L(8); G_BAR; G_WAIT_L(0); G_MMA(0, 0, At, B0); G_BAR; G_SCHED;
            G_LDB(B1, 0, 1); G_STAGEB(G_SB(0, 0), b2, ldb2, pf2);
            G_BAR; G_WAIT_L(0); G_MMA(0, 1, At, B1); G_BAR;
            G_LDA(At, 0, 1); G_STAGE(G_SA(0, 0), a2, lda2);
            G_BAR; G_WAIT_L(0); G_MMA(1, 0, At, B0); G_BAR; G_SCHED;
            G_STAGEB(G_SB(0, 1), b2 + hB2, ldb2, pf2);
            G_WAIT_V(6); G_BAR; G_MMA(1, 1, At, B1); G_BAR;
            G_LDB(B0, 1, 0); G_SCHED; G_LDA(At, 1, 0); G_STAGE(G_SA(0, 1), a2 + hA2, lda2);
            G_WAIT_L(8); G_BAR; G_WAIT_L(0); G_MMA(0, 0, At, B0); G_BAR; G_SCHED;
            G_LDB(B1, 1, 1); G_STAGEB(G_SB(1, 0), b3, ldb2, pf2);
            G_BAR; G_WAIT_L(0); G_MMA(0, 1, At, B1); G_BAR;
            G_LDA(At, 1, 1); G_STAGE(G_SA(1, 0), a3, lda2);
            G_BAR; G_WAIT_L(0); G_MMA(1, 0, At, B0); G_BAR; G_SCHED;
            G_STAGEB(G_SB(1, 1), b3 + hB2, ldb2, pf2);
            G_WAIT_V(6); G_BAR; G_MMA(1, 1, At, B1); G_BAR;
        }
        gemm_epi<PH>(p, acc, cur, wr, wc, fr, fq);
        if (!has_next) break;
#pragma unroll
        for (int a = 0; a < 2; ++a)
#pragma unroll
            for (int b = 0; b < 2; ++b)
#pragma unroll
                for (int m = 0; m < 4; ++m)
#pragma unroll
                    for (int n = 0; n < 2; ++n) acc[a][b][m][n] = (f32x4){0.f, 0.f, 0.f, 0.f};
        cur = nxt; cA = nA; cB = nB; lda = nlda; ldb = nldb; pfc = npf; ++ui;
    }
    G_WAIT_V(0);
    if (wr == 0) G_BAR;
    G_BAR;
#undef G_SA
#undef G_SB
#undef G_STAGE
#undef G_STAGEB
#undef G_LDA
#undef G_LDB
#undef G_MMA
#undef G_WAIT_V
#undef G_WAIT_L
#undef G_BAR
#undef G_SCHED
}

DI void tiny_gemm(const bf16_t* A, int lda, const bf16_t* Bt, int ldb, int K, int cgp, int lane, int wid, LAS unsigned char* lds, f32x4& c0, f32x4& c1) {
    const int fr = lane & 15, fq = lane >> 4, kper = K >> 3;
    c0 = (f32x4){0.f, 0.f, 0.f, 0.f}; c1 = c0;
    const bf16_t* ap = A + (size_t)fr * lda + fq * 8 + wid * kper; const bf16_t* b0 = Bt + (size_t)(32 * cgp + fr) * ldb + fq * 8 + wid * kper; const bf16_t* b1 = b0 + (size_t)16 * ldb;
#pragma unroll 4
    for (int k = 0; k < kper; k += 32) {
        const bf16x8 a = *(const bf16x8*)(ap + k), x = *(const bf16x8*)(b0 + k), y = *(const bf16x8*)(b1 + k);
        c0 = __builtin_amdgcn_mfma_f32_16x16x32_bf16(a, x, c0, 0, 0, 0);
        c1 = __builtin_amdgcn_mfma_f32_16x16x32_bf16(a, y, c1, 0, 0, 0);
    }
    LAS f32x4* red = (LAS f32x4*)lds;
    red[(wid * 2 + 0) * 64 + lane] = c0; red[(wid * 2 + 1) * 64 + lane] = c1;
    __syncthreads();
    if (wid == 0) {
#pragma unroll
        for (int w = 1; w < 8; ++w) { c0 += red[(w * 2 + 0) * 64 + lane]; c1 += red[(w * 2 + 1) * 64 + lane]; }
    }
    __syncthreads();
}
DI float meta_rs(const bf16_t* src, int ld, int ncol, int lane) {
    const int row = lane & 15, part = lane >> 4, per = ncol / 4; float s = 0.f;
    const bf16_t* q = src + (size_t)row * ld + part * per;
    for (int k = 0; k < per; ++k) { const float v = __uint_as_float(((unsigned)q[k]) << 16); s += v * v; }
    s += __shfl_xor(s, 16); s += __shfl_xor(s, 32);
    return rsqrtf(s / (float)ncol + EPS);
}
DI unsigned short bf1(float x) { return (unsigned short)(pk2(x, 0.f) & 0xffffu); }

template <int PH> DI void meta_phase(const Params& p, LAS unsigned char* lds) {
    unsigned char* ws = p.ws;
    const int tid = threadIdx.x, wid = tid >> 6, lane = tid & 63, fr = lane & 15, fq = lane >> 4;
    const float* cosT = (const float*)(ws + OFF_COS); const float* sinT = (const float*)(ws + OFF_SIN);
    f32x4 c0, c1;
    if (PH == 1) {
        bf16_t* pm = (bf16_t*)(ws + OFF_PROJ_META); bf16_t* vt = (bf16_t*)(ws + OFF_VSBT_META);
        for (int u = blockIdx.x; u < 96; u += gridDim.x) {
            tiny_gemm((const bf16_t*)(ws + OFF_HN_META), 1024, (const bf16_t*)(ws + OFF_WT_IN0), 1024, 1024, u, lane, wid, lds, c0, c1);
            if (wid == 0) {
                if (u < 16) { c0 = c0 * QS64; c1 = c1 * QS64; }
                if (u == 76) {
#pragma unroll
                    for (int e = 0; e < 4; ++e) { const int m = 4 * fq + e; const float c = cosT[m * 16 + fr], s = sinT[m * 16 + fr]; const float x1 = c0[e], x2 = c1[e]; c0[e] = x1 * c - x2 * s; c1[e] = x1 * s + x2 * c; }
                }
#pragma unroll
                for (int e = 0; e < 4; ++e) { const int m = 4 * fq + e; const int col = 32 * u + fr;
                    const unsigned short h0 = bf1(c0[e]), h1 = bf1(c1[e]);
                    pm[m * 3072 + col] = h0; pm[m * 3072 + col + 16] = h1;
                    if (col >= 1024 && col < 1536) { vt[(col - 1024) * 16 + m] = h0; vt[(col - 1024 + 16) * 16 + m] = h1; } }
            }
        }
    } else if (PH == 2) {
        const bf16_t* pm = (const bf16_t*)(ws + OFF_PROJ_META);
        for (int u = blockIdx.x; u < 56; u += gridDim.x) {
            if (u < 24) {
                tiny_gemm(pm + 2048, 3072, (const bf16_t*)(ws + OFF_WT_UQ), 256, 256, u, lane, wid, lds, c0, c1);
                if (wid == 0) {
                    const float rsv = meta_rs(pm + 2048, 3072, 256, lane);
                    bf16_t* qm = (bf16_t*)(ws + OFF_QM_META);
#pragma unroll
                    for (int e = 0; e < 4; ++e) { const int m = 4 * fq + e; const float rs = __shfl(rsv, m) * QS96; float x1 = c0[e] * rs, x2 = c1[e] * rs;
                        if (u % 3 == 2) { const float c = cosT[m * 16 + fr], s = sinT[m * 16 + fr]; const float y1 = x1 * c - x2 * s, y2 = x1 * s + x2 * c; x1 = y1; x2 = y2; }
                        qm[m * 768 + 32 * u + fr] = bf1(x1); qm[m * 768 + 32 * u + 16 + fr] = bf1(x2); }
                }
            } else {
                const int isv = (u >= 40), uu = isv ? u - 40 : u - 24;
                tiny_gemm(pm + 2304, 3072, (const bf16_t*)(ws + (isv ? OFF_WT_UV : OFF_WT_UK)), 256, 256, uu, lane, wid, lds, c0, c1);
                if (wid == 0) {
                    const float rsv = meta_rs(pm + 2304, 3072, 128, lane);
#pragma unroll
                    for (int e = 0; e < 4; ++e) { const int m = 4 * fq + e; const float rs = __shfl(rsv, m); const int col = 32 * uu + fr;
                        const unsigned short h0 = bf1(c0[e] * rs), h1 = bf1(c1[e] * rs);
                        if (isv) { bf16_t* vt = (bf16_t*)(ws + OFF_VMT_META); vt[col * 16 + m] = h0; vt[(col + 16) * 16 + m] = h1; }
                        else { bf16_t* km = (bf16_t*)(ws + OFF_KM_META); km[m * 512 + col] = h0; km[m * 512 + col + 16] = h1; } }
                }
            }
        }
    } else if (PH == 4) {
        float* h1 = (float*)(ws + OFF_H1_META);
        for (int u = blockIdx.x; u < 32; u += gridDim.x) {
            tiny_gemm((const bf16_t*)(ws + OFF_AO_META), 1024, (const bf16_t*)(ws + OFF_WT_OUT0), 1024, 1024, u, lane, wid, lds, c0, c1);
            if (wid == 0) {
#pragma unroll
                for (int e = 0; e < 4; ++e) { const int m = 4 * fq + e; const int col = 32 * u + fr;
                    h1[m * 1024 + col] = p.meta[m * 1024 + col] + c0[e]; h1[m * 1024 + col + 16] = p.meta[m * 1024 + col + 16] + c1[e]; }
            }
        }
    } else if (PH == 6) {
        bf16_t* pm = (bf16_t*)(ws + OFF_PROJ_META); bf16_t* vt = (bf16_t*)(ws + OFF_VSBT_META);
        for (int u = blockIdx.x; u < 8; u += gridDim.x) {
            const int cgp = 32 + u;
            tiny_gemm((const bf16_t*)(ws + OFF_HN_META), 1024, (const bf16_t*)(ws + OFF_WT_IN1), 1024, 1024, cgp, lane, wid, lds, c0, c1);
            if (wid == 0) {
#pragma unroll
                for (int e = 0; e < 4; ++e) { const int m = 4 * fq + e; const int col = 32 * cgp + fr;
                    const unsigned short h0 = bf1(c0[e]), h1v = bf1(c1[e]);
                    pm[m * 2304 + col] = h0; pm[m * 2304 + col + 16] = h1v;
                    vt[(col - 1024) * 16 + m] = h0; vt[(col - 1024 + 16) * 16 + m] = h1v; }
            }
        }
    }
}

DI void transpose_item(const float* W, int ldw, int Kv, int Nv, int k0, int n0, const float* gain, bf16_t* dst, int ldd, int drow0, int dcol0, LAS float* scr, int lane) {
    const int n = n0 + (lane & 31);
#pragma unroll 8
    for (int i = 0; i < 32; ++i) { const int kk = 2 * i + (lane >> 5), k = k0 + kk;
        float v = 0.f; if (k < Kv && n < Nv) { v = W[(size_t)k * ldw + n]; if (gain) v *= gain[k]; }
        scr[kk * 33 + (lane & 31)] = v; }
    asm volatile("s_waitcnt lgkmcnt(0)" ::: "memory");
    const int c = lane & 7;
#pragma unroll
    for (int j = 0; j < 4; ++j) { const int nn = (lane >> 3) + 8 * j; const LAS float* q = scr + (8 * c) * 33 + nn;
        u32x4 o; o.x = pk2(q[0 * 33], q[1 * 33]); o.y = pk2(q[2 * 33], q[3 * 33]); o.z = pk2(q[4 * 33], q[5 * 33]); o.w = pk2(q[6 * 33], q[7 * 33]);
        *(u32x4*)(dst + (size_t)(drow0 + nn) * ldd + dcol0 + 8 * c) = o; }
    asm volatile("s_waitcnt lgkmcnt(0)" ::: "memory");
}
DI void load_row(const float* x, const bf16_t* da, const bf16_t* db, int lane, f32x4 (&v)[4]) {
#pragma unroll
    for (int j = 0; j < 4; ++j) v[j] = ((const f32x4*)x)[lane + 64 * j];
    if (da) {
#pragma unroll
        for (int j = 0; j < 4; ++j) { const u32x2 q = ((const u32x2*)da)[lane + 64 * j]; v[j][0] += bflo(q.x); v[j][1] += bfhi(q.x); v[j][2] += bflo(q.y); v[j][3] += bfhi(q.y); }
    }
    if (db) {
#pragma unroll
        for (int j = 0; j < 4; ++j) { const u32x2 q = ((const u32x2*)db)[lane + 64 * j]; v[j][0] += bflo(q.x); v[j][1] += bfhi(q.x); v[j][2] += bflo(q.y); v[j][3] += bfhi(q.y); }
    }
}
DI float row_ssq(const f32x4 (&v)[4]) { float s = 0.f;
#pragma unroll
    for (int j = 0; j < 4; ++j) s += v[j][0] * v[j][0] + v[j][1] * v[j][1] + v[j][2] * v[j][2] + v[j][3] * v[j][3];
    return s; }
DI void norm_rows_bf16(const float* x, const bf16_t* da, size_t r0, size_t r1, bool two, const float* g, bf16_t* dst, int lane) {
    f32x4 v[4], w[4];
    load_row(x + r0 * 1024, da ? da + r0 * 1024 : nullptr, nullptr, lane, v);
    if (two) load_row(x + r1 * 1024, da ? da + r1 * 1024 : nullptr, nullptr, lane, w);
    else {
#pragma unroll
        for (int j = 0; j < 4; ++j) w[j] = (f32x4){0.f, 0.f, 0.f, 0.f};
    }
    const float rs = rsqrtf(wave_sum(row_ssq(v)) * (1.f / 1024.f) + EPS), rt = rsqrtf(wave_sum(row_ssq(w)) * (1.f / 1024.f) + EPS);
#pragma unroll
    for (int j = 0; j < 4; ++j) { const f32x4 gg = ((const f32x4*)g)[lane + 64 * j]; st4(dst + r0 * 1024 + 4 * (lane + 64 * j), v[j] * rs * gg); if (two) st4(dst + r1 * 1024 + 4 * (lane + 64 * j), w[j] * rt * gg); }
}
DI void norm_rows_f32(const float* x, const bf16_t* da, const bf16_t* db, size_t r0, size_t r1, bool two, const float* g, float* out, int lane) {
    f32x4 v[4], w[4];
    load_row(x + r0 * 1024, da + r0 * 1024, db + r0 * 1024, lane, v);
    if (two) load_row(x + r1 * 1024, da + r1 * 1024, db + r1 * 1024, lane, w);
    else {
#pragma unroll
        for (int j = 0; j < 4; ++j) w[j] = (f32x4){0.f, 0.f, 0.f, 0.f};
    }
    const float rs = rsqrtf(wave_sum(row_ssq(v)) * (1.f / 1024.f) + EPS), rt = rsqrtf(wave_sum(row_ssq(w)) * (1.f / 1024.f) + EPS);
#pragma unroll
    for (int j = 0; j < 4; ++j) { const f32x4 gg = ((const f32x4*)g)[lane + 64 * j]; ((f32x4*)(out + r0 * 1024))[lane + 64 * j] = v[j] * rs * gg; if (two) ((f32x4*)(out + r1 * 1024))[lane + 64 * j] = w[j] * rt * gg; }
}

DI void prep_phase(const Params& p, LAS unsigned char* lds) {
    unsigned char* ws = p.ws;
    const int tid = threadIdx.x, wid = tid >> 6, lane = tid & 63;
    constexpr int J1 = 16 * 96, J2 = 4 * 24, J3 = 4 * 32, J4 = 16 * 32, J5 = 16 * 72, J6 = 16 * 32, NJ = J1 + J2 + J3 + J4 + J5 + J6;
    LAS float* scr = (LAS float*)(lds + wid * 8448);
    for (int job = blockIdx.x * 8 + wid; job < NJ; job += gridDim.x * 8) {
        int r = job;
        if (r < J1) { const int nt_ = r / 16, kt = r % 16; transpose_item(p.ev_w_in, 2976, 1024, 2976, kt * 64, nt_ * 32, nullptr, (bf16_t*)(ws + OFF_WT_IN0), 1024, nt_ * 32, kt * 64, scr, lane); continue; } r -= J1;
        if (r < J2) { const int nt_ = r / 4, kt = r % 4; transpose_item(p.ev_w_uq, 768, 256, 768, kt * 64, nt_ * 32, p.ev_qg, (bf16_t*)(ws + OFF_WT_UQ), 256, nt_ * 32, kt * 64, scr, lane); continue; } r -= J2;
        if (r < J3) { const int nts = r / 4, kt = r % 4;
            transpose_item(p.ev_w_ukv, 1024, 128, 1024, kt * 64, nts * 32, p.ev_kvg, (bf16_t*)(ws + (((nts >> 1) & 1) ? OFF_WT_UV : OFF_WT_UK)), 256, (nts >> 2) * 64 + (nts & 1) * 32, kt * 64, scr, lane); continue; } r -= J3;
        if (r < J4) { const int nt_ = r / 16, kt = r % 16; transpose_item(p.ev_w_out, 1024, 1024, 1024, kt * 64, nt_ * 32, nullptr, (bf16_t*)(ws + OFF_WT_OUT0), 1024, nt_ * 32, kt * 64, scr, lane); continue; } r -= J4;
        if (r < J5) { const int nt_ = r / 16, kt = r % 16; transpose_item(p.od_w_in, 2304, 1024, 2304, kt * 64, nt_ * 32, nullptr, (bf16_t*)(ws + OFF_WT_IN1), 1024, nt_ * 32, kt * 64, scr, lane); continue; } r -= J5;
        { const int nt_ = r / 16, kt = r % 16; transpose_item(p.od_w_out, 1024, 1024, 1024, kt * 64, nt_ * 32, nullptr, (bf16_t*)(ws + OFF_WT_OUT1), 1024, nt_ * 32, kt * 64, scr, lane); }
    }
    const int gtid = blockIdx.x * 512 + tid, ngt = gridDim.x * 512;
    for (int i = gtid; i < R; i += ngt) { ((float*)(ws + OFF_SSQ_Q))[i] = 0.f; ((float*)(ws + OFF_SSQ_KV))[i] = 0.f; }
    for (int i = gtid; i < 2064 * 16; i += ngt) {
        const int pos = i >> 4, j = i & 15;
        double inv = 1.0; { const int jq = j >> 2, jr = j & 3; for (int q = 0; q < jq; ++q) inv *= 0.1; inv *= (jr == 0 ? 1.0 : jr == 1 ? 0.5623413251903491 : jr == 2 ? 0.31622776601683794 : 0.1778279410038923); }
        double ang = (double)pos * inv; const double TWO_PI = 6.283185307179586476925;
        ang -= TWO_PI * __builtin_rint(ang * (1.0 / TWO_PI));
        const double x2 = ang * ang; double sn = 0.0, cs = 0.0, ts = ang, tc = 1.0;
        for (int k = 0; k < 16; ++k) { sn += ts; cs += tc; tc *= -x2 / (double)((2 * k + 1) * (2 * k + 2)); ts *= -x2 / (double)((2 * k + 2) * (2 * k + 3)); }
        ((float*)(ws + OFF_COS))[i] = (float)cs; ((float*)(ws + OFF_SIN))[i] = (float)sn;
    }
    const int gw = blockIdx.x * 8 + wid, ngw = gridDim.x * 8;
    for (int row = gw; row < R; row += 2 * ngw) { const int r1 = row + ngw; const bool two = r1 < R;
        norm_rows_bf16(p.x, nullptr, (size_t)row, (size_t)(two ? r1 : row), two, p.norm_g, (bf16_t*)(ws + OFF_HN), lane); }
    for (int row = gw; row < NMETA; row += ngw) norm_rows_bf16(p.meta, nullptr, (size_t)row, (size_t)row, false, p.norm_g, (bf16_t*)(ws + OFF_HN_META), lane);
}

DI f32x16 mfma32(bf16x8 a, bf16x8 b, f32x16 c) { return __builtin_amdgcn_mfma_f32_32x32x16_bf16(a, b, c, 0, 0, 0); }
constexpr int VSTR = 72;

template <int NKS, int KSTR>
DI void k_frags(LAS const unsigned char* kt, int sub, int ql, int hf, bf16x8 (&kf)[NKS]) {
    LAS const unsigned char* kp = kt + (32 * sub + ql) * (KSTR * 2) + hf * 16;
#pragma unroll
    for (int ks = 0; ks < NKS; ++ks) kf[ks] = *(LAS const bf16x8*)(kp + ks * 32);
}
template <int NKS>
DI f32x16 qk_mma(const bf16x8 (&kf)[NKS], const bf16x8 (&qf)[NKS], f32x16 s) {
#pragma unroll
    for (int ks = 0; ks < NKS; ++ks) s = mfma32(kf[ks], qf[ks], s);
    return s;
}
template <int VSB>
DI void v_frags(LAS const unsigned char* vt, int sub, int ql, int hf, bf16x8 (&vf)[2][2]) {
#pragma unroll
    for (int s2 = 0; s2 < 2; ++s2)
#pragma unroll
        for (int dt = 0; dt < 2; ++dt) vf[s2][dt] = *(LAS const bf16x8*)(vt + (32 * dt + ql) * VSB + (2 * sub + s2) * 32 + hf * 16);
}
DI void pv_mma(const bf16x8 (&vf)[2][2], const f32x16& pr, f32x16 (&O)[2]) {
#pragma unroll
    for (int s2 = 0; s2 < 2; ++s2) {
        u32x4 pp; pp.x = pk2(pr[8 * s2 + 0], pr[8 * s2 + 1]); pp.y = pk2(pr[8 * s2 + 2], pr[8 * s2 + 3]); pp.z = pk2(pr[8 * s2 + 4], pr[8 * s2 + 5]); pp.w = pk2(pr[8 * s2 + 6], pr[8 * s2 + 7]);
        const bf16x8 pf = __builtin_bit_cast(bf16x8, pp);
#pragma unroll
        for (int dt = 0; dt < 2; ++dt) O[dt] = mfma32(vf[s2][dt], pf, O[dt]);
    }
}
DI void vt_store(LAS unsigned char* rowp, int c, u32x4 v) {
    LAS unsigned char* q = rowp + 32 * (c >> 1) + 8 * (c & 1);
    u32x2 lo; lo.x = v.x; lo.y = v.y; u32x2 hi; hi.x = v.z; hi.y = v.w;
    *(LAS u32x2*)q = lo; *(LAS u32x2*)(q + 16) = hi;
}
DI f32x16 splat16(float v) { f32x16 s;
#pragma unroll
    for (int i = 0; i < 16; ++i) s[i] = v;
    return s; }
constexpr float SM_TAU = 8.f;
DI void softmax_update(f32x16 (&s)[2], const bool (&have)[2], bool first, int hf, float& mrun, float& lpart, f32x16 (&O)[2]) {
    int im = (int)0x80000000;
#pragma unroll
    for (int t = 0; t < 2; ++t) if (have[t]) {
#pragma unroll
        for (int i = 0; i < 16; i += 2) { const int a = (int)__float_as_uint(s[t][i]), b = (int)__float_as_uint(s[t][i + 1]); const int m2 = a > b ? a : b; im = im > m2 ? im : m2; }
    }
    if (first || __any(__uint_as_float((unsigned)im) > SM_TAU)) {
        float mx = -1e30f;
#pragma unroll
        for (int t = 0; t < 2; ++t) if (have[t]) {
#pragma unroll
            for (int i = 0; i < 16; ++i) mx = __builtin_fmaxf(mx, s[t][i]);
        }
        mx = __builtin_fmaxf(mx, xor32(mx, hf));
        const float d = first ? mx : __builtin_fmaxf(mx, 0.f);
        const float alpha = fexp2(-d);
        mrun += d; lpart *= alpha;
#pragma unroll
        for (int i = 0; i < 16; ++i) { O[0][i] *= alpha; O[1][i] *= alpha; }
#pragma unroll
        for (int t = 0; t < 2; ++t) if (have[t]) {
#pragma unroll
            for (int i = 0; i < 16; ++i) s[t][i] -= d;
        }
    }
    f32x2_t ps = {0.f, 0.f};
#pragma unroll
    for (int t = 0; t < 2; ++t) if (have[t]) {
#pragma unroll
        for (int i = 0; i < 16; i += 2) { f32x2_t e; e[0] = fexp2(s[t][i]); e[1] = fexp2(s[t][i + 1]); s[t][i] = e[0]; s[t][i + 1] = e[1]; ps += e; }
    }
    lpart += ps[0] + ps[1];
}
DI void attn_store(const f32x16 (&O)[2], float inv, const u32x4 (&gq)[4], bf16_t* orow, int hf) {
#pragma unroll
    for (int dt = 0; dt < 2; ++dt)
#pragma unroll
        for (int ap = 0; ap < 2; ++ap) {
            float A[4], B[4];
#pragma unroll
            for (int e = 0; e < 4; ++e) {
                const unsigned a = __float_as_uint(O[dt][8 * ap + e] * inv), b = __float_as_uint(O[dt][8 * ap + 4 + e] * inv);
                auto r = __builtin_amdgcn_permlane32_swap(a, b, false, false);
                A[e] = __uint_as_float(r[0]); B[e] = __uint_as_float(r[1]);
            }
            const u32x4 g = gq[2 * dt + ap];
            const float g0 = bflo(g.x), g1 = bfhi(g.x), g2 = bflo(g.y), g3 = bfhi(g.y), g4 = bflo(g.z), g5 = bfhi(g.z), g6 = bflo(g.w), g7 = bfhi(g.w);
            f32x4 lo, hi;
            lo[0] = A[0] * g0 * __builtin_amdgcn_rcpf(1.f + __expf(-g0)); lo[1] = A[1] * g1 * __builtin_amdgcn_rcpf(1.f + __expf(-g1));
            lo[2] = A[2] * g2 * __builtin_amdgcn_rcpf(1.f + __expf(-g2)); lo[3] = A[3] * g3 * __builtin_amdgcn_rcpf(1.f + __expf(-g3));
            hi[0] = B[0] * g4 * __builtin_amdgcn_rcpf(1.f + __expf(-g4)); hi[1] = B[1] * g5 * __builtin_amdgcn_rcpf(1.f + __expf(-g5));
            hi[2] = B[2] * g6 * __builtin_amdgcn_rcpf(1.f + __expf(-g6)); hi[3] = B[3] * g7 * __builtin_amdgcn_rcpf(1.f + __expf(-g7));
            st8(orow + 32 * dt + 16 * ap + 8 * hf, lo, hi);
        }
}

template <bool MASK>
DI void sb_math(const f32x16& s, int limh, int hf, float& carry, f32x16& pr) {
    f32x16 lg, n1;
#pragma unroll
    for (int i = 0; i < 16; ++i) {
        const float z = __builtin_amdgcn_fmed3f(s[i], -100.f, 100.f);
        const float l = flog2(1.f + fexp2(-z));
        if (MASK) { const bool vis = ((8 * (i >> 2) + (i & 3)) < limh); lg[i] = vis ? l : 1e30f; n1[i] = vis ? (l + z) : 0.f; }
        else { lg[i] = l; n1[i] = l + z; }
    }
    float gs[4], og[4];
#pragma unroll
    for (int a = 0; a < 4; ++a) { gs[a] = (n1[4 * a] + n1[4 * a + 1]) + (n1[4 * a + 2] + n1[4 * a + 3]); og[a] = xor32(gs[a], hf); }
    float run = carry;
#pragma unroll
    for (int a = 3; a >= 0; --a) {
        float t = run + (hf ? 0.f : og[a]);
        pr[4 * a + 3] = fexp2(-(lg[4 * a + 3] + t)); t += n1[4 * a + 3];
        pr[4 * a + 2] = fexp2(-(lg[4 * a + 2] + t)); t += n1[4 * a + 2];
        pr[4 * a + 1] = fexp2(-(lg[4 * a + 1] + t)); t += n1[4 * a + 1];
        pr[4 * a + 0] = fexp2(-(lg[4 * a + 0] + t));
        run += gs[a] + og[a];
    }
    carry = run;
}

template <int MODE>
DI void attn_item(const Params& p, LAS unsigned char* lds, int b, int h, int qb, bool metaq) {
    constexpr int DK = (MODE == 1) ? 96 : 64, KSTR = DK + 8, NKS = DK / 16;
    constexpr int KBYTES = 64 * KSTR * 2, VBYTES = 64 * VSTR * 2, BUF = KBYTES + VBYTES;
    unsigned char* ws = p.ws;
    const int tid = threadIdx.x, wid = __builtin_amdgcn_readfirstlane(tid >> 6), lane = tid & 63, ql = lane & 31, hf = lane >> 5;
    const int ldp = (MODE == 2) ? 2304 : 3072;
    const bf16_t* proj = (const bf16_t*)(ws + OFF_PROJ); const bf16_t* projm = (const bf16_t*)(ws + OFF_PROJ_META);
    const bf16_t *Kreal, *Kmeta, *Krreal = nullptr, *Krmeta = nullptr, *Vtreal, *Vtmeta; int ldk;
    if (MODE == 0) { Kreal = proj + (size_t)b * SEQ * 3072 + 512 + h * 64; Kmeta = projm + 512 + h * 64; ldk = 3072;
        Vtreal = (const bf16_t*)(ws + OFF_VSBT) + (size_t)(h * 64) * R + b * SEQ; Vtmeta = (const bf16_t*)(ws + OFF_VSBT_META) + h * 64 * 16; }
    else if (MODE == 1) { Kreal = (const bf16_t*)(ws + OFF_KM) + (size_t)b * SEQ * 512 + h * 64; Kmeta = (const bf16_t*)(ws + OFF_KM_META) + h * 64; ldk = 512;
        Krreal = proj + (size_t)b * SEQ * 3072 + 2432; Krmeta = projm + 2432;
        Vtreal = (const bf16_t*)(ws + OFF_VMT) + (size_t)(h * 64) * R + b * SEQ; Vtmeta = (const bf16_t*)(ws + OFF_VMT_META) + h * 64 * 16; }
    else { Kreal = proj + (size_t)b * SEQ * 2304 + 1024 + h * 64; Kmeta = projm + 1024 + h * 64; ldk = 2304;
        Vtreal = (const bf16_t*)(ws + OFF_VSBT) + (size_t)(128 + h * 64) * R + b * SEQ; Vtmeta = (const bf16_t*)(ws + OFF_VSBT_META) + (128 + h * 64) * 16; }
    const int head = (MODE == 2) ? h * 8 + wid : h;
    int qrow;
    bool wactive = true;
    if (MODE == 2) qrow = 32 * qb + ql;
    else if (metaq) { qrow = (ql < 16) ? ql : 15; wactive = (wid == 0); }
    else qrow = 256 * qb + 32 * wid + ql;
    const bf16_t* qptr;
    if (MODE == 0) qptr = metaq ? projm + (size_t)qrow * 3072 + h * 64 : proj + ((size_t)b * SEQ + qrow) * 3072 + h * 64;
    else if (MODE == 1) qptr = metaq ? (const bf16_t*)(ws + OFF_QM_META) + (size_t)qrow * 768 + h * 96 : (const bf16_t*)(ws + OFF_QM) + ((size_t)b * SEQ + qrow) * 768 + h * 96;
    else qptr = proj + ((size_t)b * SEQ + qrow) * 2304 + head * 64;
    bf16x8 qf[NKS];
#pragma unroll
    for (int ks = 0; ks < NKS; ++ks) qf[ks] = *(const bf16x8*)(qptr + 16 * ks + 8 * hf);
    int T, ntiles, t0 = 0;
    if (MODE == 2) { const int lo = 32 * qb - 127; t0 = (lo > 0 ? lo : 0) >> 6; T = (qb >> 1) - t0 + 1; ntiles = T + 1; }
    else { T = metaq ? 0 : 4 * (qb + 1); ntiles = T + 1; }
#define TILE_OF(j, ism, key0) do { if (MODE == 0) { ism = ((j) >= T); key0 = 64 * (T - 1 - (j)); } else if (MODE == 1) { ism = ((j) == 0); key0 = 64 * ((j) - 1); } else { ism = ((j) == 0); key0 = 64 * (t0 + (j) - 1); } } while (0)
    u32x4 kreg, krreg, vreg;
    krreg = (u32x4){0u, 0u, 0u, 0u};
#define ISSUE(j) do { bool ism_; int key0_; TILE_OF(j, ism_, key0_); \
        { const int row = tid >> 3, ch = tid & 7; const int rr = ism_ ? (row < 16 ? row : 15) : key0_ + row; kreg = *(const u32x4*)((ism_ ? Kmeta : Kreal) + (size_t)rr * ldk + ch * 8); } \
        if (MODE == 1) { if (tid < 256) { const int row = tid >> 2, ch = tid & 3; const int rr = ism_ ? (row < 16 ? row : 15) : key0_ + row; krreg = *(const u32x4*)((ism_ ? Krmeta : Krreal) + (size_t)rr * 3072 + ch * 8); } } \
        { const int d = tid >> 3, ch = tid & 7; \
          if (ism_) { vreg = (u32x4){0u, 0u, 0u, 0u}; if (ch < 2) vreg = *(const u32x4*)(Vtmeta + d * 16 + ch * 8); } \
          else vreg = *(const u32x4*)(Vtreal + (size_t)d * R + key0_ + ch * 8); } } while (0)
#define STASH(buf) do { LAS unsigned char* kb_ = lds + (buf) * BUF; LAS unsigned char* vb_ = kb_ + KBYTES; \
        *(LAS u32x4*)(kb_ + (tid >> 3) * (KSTR * 2) + (tid & 7) * 16) = kreg; \
        if (MODE == 1) { if (tid < 256) *(LAS u32x4*)(kb_ + (tid >> 2) * (KSTR * 2) + 128 + (tid & 3) * 16) = krreg; } \
        vt_store(vb_ + (tid >> 3) * (VSTR * 2), tid & 7, vreg); } while (0)

    f32x16 O[2];
#pragma unroll
    for (int i = 0; i < 16; ++i) { O[0][i] = 0.f; O[1][i] = 0.f; }
    float carry = 0.f;
    float mrun = 0.f, lpart = 0.f;
    bool sm_first = true;


    bool wdone = !wactive;
    LAS int* flags = (LAS int*)(lds + 65536);
    ISSUE(0); STASH(0); __syncthreads();
    for (int j = 0; j < ntiles; ++j) {
        if (j + 1 < ntiles) ISSUE(j + 1);
        bool ism; int key0; TILE_OF(j, ism, key0);
        LAS const unsigned char* kt = lds + (j & 1) * BUF; LAS const unsigned char* vt = kt + KBYTES;
        if (wactive && !wdone) {
            if (MODE == 0) {
#pragma unroll
                for (int sb = 1; sb >= 0; --sb) {
                    int lim; bool needmask = true;
                    if (ism) { if (sb == 1) continue; lim = metaq ? (ql < 16 ? ql : 16) : 16; }
                    else { const int rel = (key0 >> 5) + sb - (8 * qb + wid); if (rel > 0) continue; lim = (rel == 0) ? ql : 64; needmask = (rel == 0); }
                    const int limh = lim - 4 * hf;
                    bf16x8 kf[NKS], vf[2][2];
                    k_frags<NKS, KSTR>(kt, sb, ql, hf, kf);
                    __builtin_amdgcn_sched_barrier(0);
                    const f32x16 s = qk_mma<NKS>(kf, qf, splat16(0.f));
                    f32x16 pr;
                    if (needmask) sb_math<true>(s, limh, hf, carry, pr); else sb_math<false>(s, limh, hf, carry, pr);
                    v_frags<VSTR * 2>(vt, sb, ql, hf, vf);
                    pv_mma(vf, pr, O);
                }
            } else {
                f32x16 s[2]; bool have[2], needmask[2]; int hi[2];
#pragma unroll
                for (int sb = 0; sb < 2; ++sb) {
                    have[sb] = true; needmask[sb] = true;
                    if (ism) { if (sb == 1) have[sb] = false; hi[sb] = (metaq ? (ql + 1 < 16 ? ql + 1 : 16) : 16) - 4 * hf - 1; }
                    else { const int rel = (key0 >> 5) + sb - (8 * qb + wid); if (rel > 0) have[sb] = false; hi[sb] = ((rel == 0) ? ql + 1 : 64) - 4 * hf - 1; needmask[sb] = (rel == 0); }
                }
                if (have[0] || have[1]) {
                    bf16x8 kf[NKS], vf0[2][2], vf1[2][2];
                    if (have[0]) { k_frags<NKS, KSTR>(kt, 0, ql, hf, kf);
                        __builtin_amdgcn_sched_barrier(0);
                        s[0] = qk_mma<NKS>(kf, qf, splat16(-mrun)); }
                    if (have[1]) { k_frags<NKS, KSTR>(kt, 1, ql, hf, kf);
                        __builtin_amdgcn_sched_barrier(0);
                        s[1] = qk_mma<NKS>(kf, qf, splat16(-mrun)); }
                    if (have[0]) v_frags<VSTR * 2>(vt, 0, ql, hf, vf0);
                    if (have[1]) v_frags<VSTR * 2>(vt, 1, ql, hf, vf1);
                    __builtin_amdgcn_sched_barrier(0);
#pragma unroll
                    for (int sb = 0; sb < 2; ++sb) if (have[sb] && needmask[sb]) {
#pragma unroll
                        for (int i = 0; i < 16; ++i) { const int cst = 8 * (i >> 2) + (i & 3); s[sb][i] = (cst <= hi[sb]) ? s[sb][i] : -1e30f; }
                    }
                    softmax_update(s, have, sm_first, hf, mrun, lpart, O); sm_first = false;
                    if (have[0]) pv_mma(vf0, s[0], O);
                    if (have[1]) pv_mma(vf1, s[1], O);
                }
            }
        }
        if (MODE == 0) {
            if (!wdone) wdone = __all(carry > -SB_THRESH);
            if (lane == 0) flags[(j & 1) * 8 + wid] = wdone ? 1 : 0;
        }
        if (j + 1 < ntiles) STASH((j + 1) & 1);
        __syncthreads();
        if (MODE == 0) {
            int alld = 1;
#pragma unroll
            for (int w = 0; w < 8; ++w) alld &= flags[(j & 1) * 8 + w];
            if (alld) break;
        }
    }
#undef TILE_OF
#undef ISSUE
#undef STASH
    int qrow_e = qrow; asm volatile("" : "+v"(qrow_e));
    if (wactive && (!metaq || ql < 16)) {
        float inv = 1.f;
        if (MODE != 0) { const float l = lpart + xor32(lpart, hf); inv = 1.f / l; }
        const bf16_t* gptr; bf16_t* optr;
        if (MODE == 0) { gptr = metaq ? projm + (size_t)qrow_e * 3072 + 1536 + h * 64 : proj + ((size_t)b * SEQ + qrow_e) * 3072 + 1536 + h * 64;
            optr = metaq ? (bf16_t*)(ws + OFF_AO_META) + (size_t)qrow_e * 1024 + h * 64 : (bf16_t*)(ws + OFF_HN) + ((size_t)b * SEQ + qrow_e) * 1024 + h * 64; }
        else if (MODE == 1) { gptr = metaq ? projm + (size_t)qrow_e * 3072 + 2464 + h * 64 : proj + ((size_t)b * SEQ + qrow_e) * 3072 + 2464 + h * 64;
            optr = metaq ? (bf16_t*)(ws + OFF_AO_META) + (size_t)qrow_e * 1024 + 512 + h * 64 : (bf16_t*)(ws + OFF_HN) + ((size_t)b * SEQ + qrow_e) * 1024 + 512 + h * 64; }
        else { gptr = proj + ((size_t)b * SEQ + qrow_e) * 2304 + 1280 + head * 64; optr = (bf16_t*)(ws + OFF_HN) + ((size_t)b * SEQ + qrow_e) * 1024 + head * 64; }
        u32x4 gq4[4];
#pragma unroll
        for (int k = 0; k < 4; ++k) gq4[k] = *(const u32x4*)(gptr + 16 * k + 8 * hf);
        attn_store(O, inv, gq4, optr, hf);
    }
}

DI void attn0_phase(const Params& p, LAS unsigned char* lds) {
    for (int it = blockIdx.x; it < 2048 + 16; it += gridDim.x) {
        if (it < 2048) {
            const int j = it >> 8, c = it & 255, b = c >> 4, h = (c & 15) >> 1, st = c & 1, type = j & 1, qi = j >> 1;
            const int sel = type ? st : 1 - st;
            const int qb = sel ? (qi == 0 ? 6 : qi == 1 ? 5 : qi == 2 ? 2 : 1) : (qi == 0 ? 7 : qi == 1 ? 4 : qi == 2 ? 3 : 0);
            if (type == 0) attn_item<0>(p, lds, b, h, qb, false); else attn_item<1>(p, lds, b, h, qb, false);
        } else { const int hh = it - 2048; if (hh < 8) attn_item<0>(p, lds, 0, hh, 0, true); else attn_item<1>(p, lds, 0, hh - 8, 0, true); }
    }
}
struct SwaRegs { u32x4 kr[4], vr[4], mr; };
DI void swa_load(const Params& p, int b, int kvh, int I, SwaRegs& g) {
    unsigned char* ws = p.ws; const int tid = threadIdx.x;
    const bf16_t* proj = (const bf16_t*)(ws + OFF_PROJ); const bf16_t* projm = (const bf16_t*)(ws + OFF_PROJ_META);
    const int kb = 128 * I - 128;
    const bf16_t* Kreal = proj + (size_t)b * SEQ * 2304 + 1024 + kvh * 64; const bf16_t* Kmeta = projm + 1024 + kvh * 64;
    const bf16_t* Vtreal = (const bf16_t*)(ws + OFF_VSBT) + (size_t)(128 + kvh * 64) * R + b * SEQ; const bf16_t* Vtmeta = (const bf16_t*)(ws + OFF_VSBT_META) + (128 + kvh * 64) * 16;
    g.mr = (u32x4){0u, 0u, 0u, 0u};
#pragma unroll
    for (int i = 0; i < 4; ++i) { const int c = tid + 512 * i, row = c >> 3, ch = c & 7, key = kb + row;
        g.kr[i] = (u32x4){0u, 0u, 0u, 0u}; if (key >= 0) g.kr[i] = *(const u32x4*)(Kreal + (size_t)key * 2304 + ch * 8); }
#pragma unroll
    for (int i = 0; i < 4; ++i) { const int c = tid + 512 * i, d = c >> 5, ch = c & 31, key = kb + 8 * ch;
        g.vr[i] = (u32x4){0u, 0u, 0u, 0u}; if (key >= 0) g.vr[i] = *(const u32x4*)(Vtreal + (size_t)d * R + key); }
    if (tid < 128) { const int row = tid >> 3, ch = tid & 7; g.mr = *(const u32x4*)(Kmeta + row * 2304 + ch * 8); }
    else if (tid < 256) { const int t = tid - 128, d = t >> 1, ch = t & 1; g.mr = *(const u32x4*)(Vtmeta + d * 16 + ch * 8); }
}
DI void swa_stash(LAS unsigned char* lds, const SwaRegs& g) {
    constexpr int KSB = 144, VSB = 592, KBYTES = 288 * KSB;
    const int tid = threadIdx.x; LAS unsigned char* kbuf = lds; LAS unsigned char* vbuf = lds + KBYTES;
#pragma unroll
    for (int i = 0; i < 4; ++i) { const int c = tid + 512 * i; *(LAS u32x4*)(kbuf + (c >> 3) * KSB + (c & 7) * 16) = g.kr[i]; vt_store(vbuf + (c >> 5) * VSB, c & 31, g.vr[i]); }
    if (tid < 128) *(LAS u32x4*)(kbuf + (256 + (tid >> 3)) * KSB + (tid & 7) * 16) = g.mr;
    else if (tid < 256) { const int t = tid - 128; vt_store(vbuf + (t >> 1) * VSB, 32 + (t & 1), g.mr); }
    else if (tid < 384) { const int t = tid - 256; *(LAS u32x4*)(vbuf + (t >> 1) * VSB + 544 + (t & 1) * 16) = (u32x4){0u, 0u, 0u, 0u}; }
}
DI void swa_compute(const Params& p, LAS unsigned char* lds, int b, int kvh, int I) {
    constexpr int KSB = 144, VSB = 592, KBYTES = 288 * KSB;
    unsigned char* ws = p.ws;
    const int tid = threadIdx.x, wid = __builtin_amdgcn_readfirstlane(tid >> 6), lane = tid & 63, ql = lane & 31, hf = lane >> 5;
    const bf16_t* proj = (const bf16_t*)(ws + OFF_PROJ);
    LAS unsigned char* kbuf = lds; LAS unsigned char* vbuf = lds + KBYTES;
    const int head = kvh * 8 + wid;
    const float slope2 = fexp2(-0.5f * (float)(head + 1)) * LOG2E, sink2 = p.od_sinks[head] * LOG2E;
    const bf16_t* rowp = proj + ((size_t)b * SEQ + 128 * I + ql) * 2304;
    bf16x8 qf[4];
#pragma unroll
    for (int ks = 0; ks < 4; ++ks) qf[ks] = *(const bf16x8*)(rowp + head * 64 + 16 * ks + 8 * hf);
#pragma unroll 1
    for (int qs = 0; qs < 4; ++qs) {
        const int qrow = 32 * (4 * I + qs) + ql;
        const bf16_t* nrow = rowp + (size_t)(qs < 3 ? 32 * (qs + 1) : 32 * qs) * 2304;
        bf16x8 qn[4];
#pragma unroll
        for (int ks = 0; ks < 4; ++ks) qn[ks] = *(const bf16x8*)(nrow + head * 64 + 16 * ks + 8 * hf);
        const bf16_t* gptr = rowp + (size_t)(32 * qs) * 2304 + 1280 + head * 64;
        u32x4 gq4[4];
#pragma unroll
        for (int k = 0; k < 4; ++k) gq4[k] = *(const u32x4*)(gptr + 16 * k + 8 * hf);
        f32x16 O[2];
#pragma unroll
        for (int i = 0; i < 16; ++i) { O[0][i] = 0.f; O[1][i] = 0.f; }
        float mrun = sink2, lpart = (hf == 0) ? 1.f : 0.f;
#pragma unroll 1
        for (int pr_ = 0; pr_ < 3; ++pr_) {
            int subs[2]; subs[0] = (pr_ == 0) ? 8 : qs + 2 * pr_ - 1; subs[1] = qs + 2 * pr_;
            f32x16 s[2]; bool have[2]; int lo_[2], hi_[2]; float nb_[2];
#pragma unroll
            for (int t = 0; t < 2; ++t) {
                const int sub = subs[t]; int lo = -1000, hi = 1000; float nb;
                if (sub == 8) { have[t] = true; hi = 15 - 4 * hf; nb = -slope2 * (float)(16 + qrow - 4 * hf); }
                else { have[t] = !(I == 0 && sub < 4); const int k = qs + 4 - sub; const int Dl = 32 * k + ql; nb = -slope2 * (float)(Dl - 4 * hf);
                    if (k == 0) hi = Dl - 4 * hf; if (k == 4) lo = Dl - 127 - 4 * hf; }
                lo_[t] = lo; hi_[t] = hi; nb_[t] = nb;
            }
            bf16x8 kf0[4], kf1[4], vf0[2][2], vf1[2][2];
            if (have[0]) k_frags<4, 72>(kbuf, subs[0], ql, hf, kf0);
            __builtin_amdgcn_sched_barrier(0);
            if (have[0]) { f32x16 ini; const float c0 = nb_[0] - mrun;
#pragma unroll
                for (int i = 0; i < 16; ++i) ini[i] = slope2 * (float)(8 * (i >> 2) + (i & 3)) + c0;
                s[0] = qk_mma<4>(kf0, qf, ini); }
            if (have[1]) k_frags<4, 72>(kbuf, subs[1], ql, hf, kf1);
            __builtin_amdgcn_sched_barrier(0);
            if (have[1]) { f32x16 ini; const float c0 = nb_[1] - mrun;
#pragma unroll
                for (int i = 0; i < 16; ++i) ini[i] = slope2 * (float)(8 * (i >> 2) + (i & 3)) + c0;
                s[1] = qk_mma<4>(kf1, qf, ini); }
#pragma unroll
            for (int t = 0; t < 2; ++t) {
                if (have[t]) {
                    if (hi_[t] < 1000) {
#pragma unroll
                        for (int i = 0; i < 16; ++i) { const int cst = 8 * (i >> 2) + (i & 3); s[t][i] = (cst <= hi_[t]) ? s[t][i] : -1e30f; }
                    }
                    if (lo_[t] > -1000) {
#pragma unroll
                        for (int i = 0; i < 16; ++i) { const int cst = 8 * (i >> 2) + (i & 3); s[t][i] = (cst >= lo_[t]) ? s[t][i] : -1e30f; }
                    }
                }
            }
            softmax_update(s, have, false, hf, mrun, lpart, O);
            if (have[0]) { v_frags<VSB>(vbuf, subs[0], ql, hf, vf0); pv_mma(vf0, s[0], O); }
            if (have[1]) { v_frags<VSB>(vbuf, subs[1], ql, hf, vf1); pv_mma(vf1, s[1], O); }
        }
        const float inv = 1.f / (lpart + xor32(lpart, hf));
        bf16_t* optr = (bf16_t*)(ws + OFF_HN) + ((size_t)b * SEQ + qrow) * 1024 + head * 64;
        attn_store(O, inv, gq4, optr, hf);
#pragma unroll
        for (int ks = 0; ks < 4; ++ks) qf[ks] = qn[ks];
    }
}
DI void attn1_phase(const Params& p, LAS unsigned char* lds) {
    for (int it = blockIdx.x; it < 512; it += gridDim.x) {
        { SwaRegs g; swa_load(p, it >> 5, (it >> 4) & 1, it & 15, g);
          __syncthreads();
          swa_stash(lds, g); }
        __syncthreads();
        swa_compute(p, lds, it >> 5, (it >> 4) & 1, it & 15);
    }
}

#define XB_TMO      128
#define XB_XCNT(j)  (256  + 64 * (j))
#define XB_XSUB(j)  (1280 + 64 * (j))
#define XB_XGEN(j)  (2304 + 64 * (j))
#define XB_TOP      3328
#define XB_TOPGEN   3392
#define XCD_BAR_WORDS 3456
#define XB_SPIN_CAP (1u << 18)
DI unsigned xb_ld(unsigned* p)              { return __hip_atomic_load(p, __ATOMIC_RELAXED, __HIP_MEMORY_SCOPE_AGENT); }
DI unsigned xb_add(unsigned* p, unsigned v) { return __hip_atomic_fetch_add(p, v, __ATOMIC_RELAXED, __HIP_MEMORY_SCOPE_AGENT); }
DI unsigned xb_xcc_id() { return (unsigned)__builtin_amdgcn_s_getreg((3 << 11) | 20) & 0xFu; }
#define XB_SPIN(cond, bar) do { unsigned _sp = 0; while (cond) { __builtin_amdgcn_s_sleep(1); \
    if ((++_sp & 255u) == 0u) { if (xb_ld(&(bar)[XB_TMO])) break; if (_sp > XB_SPIN_CAP) { atomicAdd(&(bar)[XB_TMO], 1u); break; } } } } while (0)
struct XcdBarrier { unsigned* bar; unsigned x; volatile LAS unsigned* st; };
DI XcdBarrier xcd_barrier_post(unsigned* bar, volatile LAS unsigned* st) {
    XcdBarrier b; b.bar = bar; b.x = xb_xcc_id(); b.st = st;
    if (threadIdx.x == 0) (void)xb_add(&bar[XB_XCNT(b.x)], 1u);
    return b;
}
DI void xcd_barrier_complete(unsigned* bar, unsigned x, unsigned& nloc, unsigned& nx) {
    const unsigned G = gridDim.x * gridDim.y * gridDim.z;
    unsigned sum, cnt, mine, sp = 0u;
    for (;;) {
        sum = 0u; cnt = 0u; mine = 0u;
#pragma unroll
        for (unsigned j = 0; j < 16; ++j) { const unsigned c = xb_ld(&bar[XB_XCNT(j)]); sum += c; cnt += (c > 0u) ? 1u : 0u; mine = (j == x) ? c : mine; }
        if (sum == G) break;
        __builtin_amdgcn_s_sleep(1);
        if ((++sp & 255u) == 0u) { if (xb_ld(&bar[XB_TMO])) break; if (sp > XB_SPIN_CAP) { atomicAdd(&bar[XB_TMO], 1u); break; } }
    }
    nloc = mine > 0u ? mine : 1u; nx = cnt > 0u ? cnt : 1u;
}
DI void xcd_barrier(const XcdBarrier& b) {
    asm volatile("s_waitcnt vmcnt(0)" ::: "memory");
    __syncthreads();
    if (threadIdx.x == 0) {
        unsigned* bar = b.bar;
        __builtin_amdgcn_s_waitcnt(0);
        unsigned nloc = b.st[0], nx = b.st[1];
        if (nloc == 0u) { xcd_barrier_complete(bar, b.x, nloc, nx); b.st[0] = nloc; b.st[1] = nx; }
        const unsigned old = xb_add(&bar[XB_XSUB(b.x)], 1u);
        const unsigned gen = old / nloc;
        if (old + 1u == (gen + 1u) * nloc) {
            __builtin_amdgcn_fence(__ATOMIC_RELEASE, "agent");
            asm volatile("s_waitcnt vmcnt(0)" ::: "memory");
            const unsigned og = xb_add(&bar[XB_TOP], 1u);
            const unsigned tg = og / nx;
            if (og + 1u == (tg + 1u) * nx) xb_add(&bar[XB_TOPGEN], 1u);
            else XB_SPIN(xb_ld(&bar[XB_TOPGEN]) == tg, bar);
            __builtin_amdgcn_fence(__ATOMIC_ACQUIRE, "agent");
            xb_add(&bar[XB_XGEN(b.x)], 1u);
            asm volatile("s_waitcnt vmcnt(0)" ::: "memory");
        } else {
            XB_SPIN(xb_ld(&bar[XB_XGEN(b.x)]) == gen, bar);
            __builtin_amdgcn_fence(__ATOMIC_ACQUIRE, "agent");
            asm volatile("s_waitcnt vmcnt(0)" ::: "memory");
        }
    }
    __syncthreads();
}

template <int PH> DI void run_phase(const Params& p, LAS unsigned char* lds) {
    const int tid = threadIdx.x, wid = tid >> 6, lane = tid & 63;
    if (PH == 0) prep_phase(p, lds);
    else if (PH == 1) { gemm_phase<1>(p, lds); meta_phase<1>(p, lds); }
    else if (PH == 2) { gemm_phase<2>(p, lds); meta_phase<2>(p, lds); }
    else if (PH == 3) { if (wid >= 4) __builtin_amdgcn_s_setprio(1); attn0_phase(p, lds); __builtin_amdgcn_s_setprio(0); }
    else if (PH == 4) { gemm_phase<4>(p, lds); meta_phase<4>(p, lds); }
    else if (PH == 5) {
        const int gw = blockIdx.x * 8 + wid, ngw = gridDim.x * 8;
        for (int row = gw; row < R; row += 2 * ngw) { const int r1 = row + ngw; const bool two = r1 < R;
            norm_rows_bf16(p.x, (const bf16_t*)(p.ws + OFF_D1), (size_t)row, (size_t)(two ? r1 : row), two, p.norm_g + 1024, (bf16_t*)(p.ws + OFF_HN), lane); }
        for (int row = gw; row < NMETA; row += ngw) norm_rows_bf16((const float*)(p.ws + OFF_H1_META), nullptr, (size_t)row, (size_t)row, false, p.norm_g + 1024, (bf16_t*)(p.ws + OFF_HN_META), lane);
    }
    else if (PH == 6) { gemm_phase<6>(p, lds); meta_phase<6>(p, lds); }
    else if (PH == 7) { if (wid >= 4) __builtin_amdgcn_s_setprio(1); attn1_phase(p, lds); __builtin_amdgcn_s_setprio(0); }
    else if (PH == 8) gemm_phase<8>(p, lds);
    else if (PH == 9) {
        const int gw = blockIdx.x * 8 + wid, ngw = gridDim.x * 8;
        for (int row = gw; row < R; row += 2 * ngw) { const int r1 = row + ngw; const bool two = r1 < R;
            norm_rows_f32(p.x, (const bf16_t*)(p.ws + OFF_D1), (const bf16_t*)(p.ws + OFF_D2), (size_t)row, (size_t)(two ? r1 : row), two, p.final_g, p.out, lane); }
    }
}

__global__ void __launch_bounds__(512, 2) mk_fwd(Params p) {
    extern __shared__ __attribute__((aligned(16))) unsigned char shm[];
    LAS unsigned char* lds = (LAS unsigned char*)shm;
    cg::grid_group grid = cg::this_grid();
    volatile LAS unsigned* st = (volatile LAS unsigned*)(lds + 131072);
    if (threadIdx.x == 0) { st[0] = 0u; st[1] = 0u; st[2] = 0u; st[3] = 0u; }
    __syncthreads();
    const XcdBarrier xb = xcd_barrier_post((unsigned*)(p.ws + OFF_BAR), st);
#define PHASE(n) do { if (p.ph_lo <= n && n < p.ph_hi) { run_phase<n>(p, lds); if (n + 1 < p.ph_hi) { if (p.ph_hi > 10) grid.sync(); else xcd_barrier(xb); } } } while (0)
    PHASE(0); PHASE(1); PHASE(2); PHASE(3); PHASE(4); PHASE(5); PHASE(6); PHASE(7); PHASE(8); PHASE(9);
}

extern "C" void kernel_launch(void* const* d_in, const int* in_sizes, int n_in, void* d_out, int out_size, void* d_ws, size_t ws_size, hipStream_t stream) {
    static int grid_blocks = 0;
    if (grid_blocks == 0) {
        if (n_in != 13 || ws_size < WS_END) { fprintf(stderr, "kernel_launch: unexpected inputs (n_in %d, ws %zu, need %zu)\n", n_in, ws_size, (size_t)WS_END); grid_blocks = -1; return; }
        int dev = 0, cus = 0, per_cu = 0;
        hipGetDevice(&dev);
        hipDeviceGetAttribute(&cus, hipDeviceAttributeMultiprocessorCount, dev);
        if (hipFuncSetAttribute((const void*)mk_fwd, hipFuncAttributeMaxDynamicSharedMemorySize, LDS_BYTES) != hipSuccess) { fprintf(stderr, "kernel_launch: hipFuncSetAttribute failed\n"); grid_blocks = -1; return; }
        if (hipOccupancyMaxActiveBlocksPerMultiprocessor(&per_cu, (const void*)mk_fwd, 512, LDS_BYTES) != hipSuccess || per_cu < 1) per_cu = 1;
        (void)hipGetLastError();
        grid_blocks = cus * per_cu;
    }
    if (grid_blocks < 0) return;
    Params p{};
    p.x = (const float*)d_in[0]; p.meta = (const float*)d_in[1]; p.norm_g = (const float*)d_in[2]; p.final_g = (const float*)d_in[3];
    p.ev_w_in = (const float*)d_in[4]; p.ev_qg = (const float*)d_in[5]; p.ev_kvg = (const float*)d_in[6]; p.ev_w_uq = (const float*)d_in[7];
    p.ev_w_ukv = (const float*)d_in[8]; p.ev_w_out = (const float*)d_in[9]; p.od_w_in = (const float*)d_in[10]; p.od_sinks = (const float*)d_in[11];
    p.od_w_out = (const float*)d_in[12];
    p.out = (float*)d_out; p.ws = (unsigned char*)d_ws;
    p.ph_lo = 0; p.ph_hi = 10;
    if (hipMemsetAsync((unsigned char*)d_ws + OFF_BAR, 0, BAR_BYTES, stream) != hipSuccess) { fprintf(stderr, "kernel_launch: memset of the barrier words failed\n"); return; }
    void* args[] = {&p};
    hipError_t e = hipLaunchCooperativeKernel((const void*)mk_fwd, dim3(grid_blocks), dim3(512), args, LDS_BYTES, stream);
    if (e != hipSuccess) fprintf(stderr, "cooperative launch failed: %s (grid %d)\n", hipGetErrorString(e), grid_blocks);
}
```

```cpp
#include <hip/hip_runtime.h>
#include <hip/hip_cooperative_groups.h>
#include <cstdio>
namespace cg = cooperative_groups;

#define DI __device__ __forceinline__
#define LAS __attribute__((address_space(3)))
typedef unsigned short bf16_t;
typedef short bf16x8 __attribute__((ext_vector_type(8)));
typedef short s16x4 __attribute__((ext_vector_type(4)));
typedef float f32x4 __attribute__((ext_vector_type(4)));
typedef float f32x16 __attribute__((ext_vector_type(16)));
typedef float f32x2_t __attribute__((ext_vector_type(2)));
typedef __bf16 bf16x2_t __attribute__((ext_vector_type(2)));
typedef unsigned u32x4 __attribute__((ext_vector_type(4)));
typedef unsigned u32x2 __attribute__((ext_vector_type(2)));

#ifndef COOP
#define COOP 1
#endif

constexpr int NBATCH = 16, SEQ = 2048, DM = 1024, R = NBATCH * SEQ, NMETA = 16;
constexpr float EPS = 1e-6f;
constexpr float LOG2E = 1.4426950408889634f;
constexpr int LDS_BYTES = 131072 + 256;
constexpr float QS64 = 0.125f * LOG2E, QS96 = 0.10206207261596575f * LOG2E;
constexpr float SB_THRESH = -152.f;

constexpr size_t OFF_WT_IN0 = 0;
constexpr size_t OFF_WT_UQ = OFF_WT_IN0 + (size_t)3072 * 1024 * 2;
constexpr size_t OFF_WT_UK = OFF_WT_UQ + (size_t)768 * 256 * 2;
constexpr size_t OFF_WT_UV = OFF_WT_UK + (size_t)512 * 256 * 2;
constexpr size_t OFF_WT_OUT0 = OFF_WT_UV + (size_t)512 * 256 * 2;
constexpr size_t OFF_WT_IN1 = OFF_WT_OUT0 + (size_t)1024 * 1024 * 2;
constexpr size_t OFF_WT_OUT1 = OFF_WT_IN1 + (size_t)2304 * 1024 * 2;
constexpr size_t OFF_HN = OFF_WT_OUT1 + (size_t)1024 * 1024 * 2;
constexpr size_t OFF_PROJ = OFF_HN + (size_t)R * 1024 * 2;
constexpr size_t OFF_VSBT = OFF_PROJ + (size_t)R * 3072 * 2;
constexpr size_t OFF_QM = OFF_VSBT + (size_t)512 * R * 2;
constexpr size_t OFF_KM = OFF_QM + (size_t)R * 768 * 2;
constexpr size_t OFF_VMT = OFF_KM + (size_t)R * 512 * 2;
constexpr size_t OFF_SSQ_Q = OFF_VMT + (size_t)512 * R * 2;
constexpr size_t OFF_SSQ_KV = OFF_SSQ_Q + (size_t)R * 4;
constexpr size_t OFF_COS = OFF_SSQ_KV + (size_t)R * 4;
constexpr size_t OFF_SIN = OFF_COS + (size_t)2064 * 16 * 4;
constexpr size_t OFF_HN_META = OFF_SIN + (size_t)2064 * 16 * 4;
constexpr size_t OFF_AO_META = OFF_HN_META + (size_t)16 * 1024 * 2;
constexpr size_t OFF_PROJ_META = OFF_AO_META + (size_t)16 * 1024 * 2;
constexpr size_t OFF_VSBT_META = OFF_PROJ_META + (size_t)16 * 3072 * 2;
constexpr size_t OFF_QM_META = OFF_VSBT_META + (size_t)512 * 16 * 2;
constexpr size_t OFF_KM_META = OFF_QM_META + (size_t)16 * 768 * 2;
constexpr size_t OFF_VMT_META = OFF_KM_META + (size_t)16 * 512 * 2;
constexpr size_t OFF_H1_META = OFF_VMT_META + (size_t)512 * 16 * 2;
constexpr size_t OFF_D1 = OFF_KM;
constexpr size_t OFF_D2 = OFF_PROJ;
constexpr size_t OFF_BAR = OFF_H1_META + (size_t)16 * 1024 * 4;
constexpr size_t BAR_BYTES = 16384;
constexpr size_t WS_END = OFF_BAR + BAR_BYTES;

struct Params {
    const float *x, *meta, *norm_g, *final_g, *ev_w_in, *ev_qg, *ev_kvg, *ev_w_uq, *ev_w_ukv, *ev_w_out, *od_w_in, *od_sinks, *od_w_out;
    float* out;
    unsigned char* ws;
    int ph_lo, ph_hi;
};

DI unsigned pk2(float a, float b) { f32x2_t v = {a, b}; return __builtin_bit_cast(unsigned, __builtin_convertvector(v, bf16x2_t)); }
DI float bflo(unsigned u) { return __uint_as_float(u << 16); }
DI float bfhi(unsigned u) { return __uint_as_float(u & 0xffff0000u); }
DI void st8(bf16_t* ptr, f32x4 a, f32x4 b) { u32x4 o; o.x = pk2(a[0], a[1]); o.y = pk2(a[2], a[3]); o.z = pk2(b[0], b[1]); o.w = pk2(b[2], b[3]); *(u32x4*)ptr = o; }
DI void st4(bf16_t* ptr, f32x4 v) { u32x2 o; o.x = pk2(v[0], v[1]); o.y = pk2(v[2], v[3]); *(u32x2*)ptr = o; }
DI float wave_sum(float s) {
#pragma unroll
    for (int o = 32; o >= 1; o >>= 1) s += __shfl_xor(s, o);
    return s;
}
DI float xor32(float x, int hf) {
    const unsigned xi = __float_as_uint(x); auto r = __builtin_amdgcn_permlane32_swap(xi, xi, false, false);
    return __uint_as_float(hf ? r[0] : r[1]);
}
DI float fexp2(float x) { return __builtin_amdgcn_exp2f(x); }
DI float flog2(float x) { return __builtin_amdgcn_logf(x); }

constexpr int BM = 256, BK = 64, HALF = 128, HTB = HALF * BK * 2, NXCD = 8, WGM = 8;
DI int lds_byte(int r, int c) { const int st = (r >> 4) * 2 + (c >> 5), rr = r & 15, cc = c & 31, ob = rr * 64 + cc * 2; return st * 1024 + (ob ^ (((ob >> 9) & 1) << 5)); }
DI void stage_rc(int b, int& Rr, int& Cc) { const int st = b / 1024, sb = b % 1024, swz = sb ^ (((sb >> 9) & 1) << 5); Rr = (st >> 1) * 16 + swz / 64; Cc = (st & 1) * 32 + (swz % 64) / 2; }

struct GUnit { const unsigned char* A; const unsigned char* B; int lda, ldb; int kind, row0, col0, perm; };
DI int perm32(int rho) { const int n = rho >> 4, i = rho & 15; return 8 * (i >> 2) + 4 * n + (i & 3); }

DI bool order_unit(int i, int nM, int nN, int& pm, int& pn) {
    const int nwg = nM * nN; const long L = (long)i * gridDim.x + blockIdx.x; if (L >= nwg) return false;
    int wgid = (int)L; { const int q = nwg / NXCD, r = nwg % NXCD, xcd = wgid % NXCD, off = wgid / NXCD; wgid = (xcd < r ? xcd * (q + 1) : r * (q + 1) + (xcd - r) * q) + off; }
    const int nig = WGM * nN, gid = wgid / nig, fm = gid * WGM, gsz = (nM - fm) < WGM ? (nM - fm) : WGM;
    pm = fm + ((wgid % nig) % gsz); pn = (wgid % nig) / gsz; return true;
}

template <int PH> struct PhCfg;
template <> struct PhCfg<1> { static constexpr int K = 1024, nM = 128, nN = 12; };
template <> struct PhCfg<2> { static constexpr int K = 256, nM = 128, nN = 7; };
template <> struct PhCfg<4> { static constexpr int K = 1024, nM = 128, nN = 4; };
template <> struct PhCfg<6> { static constexpr int K = 1024, nM = 128, nN = 10; };
template <> struct PhCfg<8> { static constexpr int K = 1024, nM = 128, nN = 4; };

template <int PH> DI bool get_unit(const Params& p, int i, GUnit& u) {
    int pm, pn; if (!order_unit(i, PhCfg<PH>::nM, PhCfg<PH>::nN, pm, pn)) return false;
    const unsigned char* ws = p.ws;
    if (PH == 1) {
        if (pn >= 6 && pn <= 9) pn = (pn < 8) ? pn + 2 : pn - 2;
        const unsigned char* a = ws + OFF_HN + (size_t)pm * 256 * 2048; const unsigned char* b = ws + OFF_WT_IN0 + (size_t)pn * 256 * 2048;
        u.lda = 2048; u.ldb = 2048;
        if (pn == 4 || pn == 5) { u.A = b; u.B = a; u.kind = 1; u.row0 = (pn - 4) * 256; u.col0 = pm * 256; }
        else { u.A = a; u.B = b; u.kind = 0; u.row0 = pm * 256; u.col0 = pn * 256; }
        u.perm = 1;
    } else if (PH == 2) {
        if (pn < 3) { u.A = ws + OFF_PROJ + ((size_t)pm * 256 * 3072 + 2048) * 2; u.lda = 6144; u.B = ws + OFF_WT_UQ + (size_t)pn * 256 * 512; u.ldb = 512; u.kind = 0; u.row0 = pm * 256; u.col0 = pn * 256; }
        else if (pn < 5) { u.A = ws + OFF_PROJ + ((size_t)pm * 256 * 3072 + 2304) * 2; u.lda = 6144; u.B = ws + OFF_WT_UK + (size_t)(pn - 3) * 256 * 512; u.ldb = 512; u.kind = 1; u.row0 = pm * 256; u.col0 = (pn - 3) * 256; }
        else { u.B = ws + OFF_PROJ + ((size_t)pm * 256 * 3072 + 2304) * 2; u.ldb = 6144; u.A = ws + OFF_WT_UV + (size_t)(pn - 5) * 256 * 512; u.lda = 512; u.kind = 2; u.row0 = (pn - 5) * 256; u.col0 = pm * 256; }
        u.perm = 1;
    } else if (PH == 4 || PH == 8) {
        u.A = ws + OFF_HN + (size_t)pm * 256 * 2048; u.B = ws + (PH == 4 ? OFF_WT_OUT0 : OFF_WT_OUT1) + (size_t)pn * 256 * 2048; u.lda = 2048; u.ldb = 2048; u.kind = 0; u.row0 = pm * 256; u.col0 = pn * 256; u.perm = 1;
    } else {
        const unsigned char* a = ws + OFF_HN + (size_t)pm * 256 * 2048;
        u.lda = 2048; u.ldb = 2048;
        if (pn == 9) { u.A = ws + OFF_WT_IN1 + (size_t)4 * 256 * 2048; u.B = a; u.kind = 1; u.row0 = 0; u.col0 = pm * 256; }
        else { u.A = a; u.B = ws + OFF_WT_IN1 + (size_t)pn * 256 * 2048; u.kind = 0; u.row0 = pm * 256; u.col0 = pn * 256; }
        u.perm = 1;
    }
    return true;
}

DI void rope_perm(f32x4& v0, f32x4& v1, const float* cs, const float* sn, int fq) {
    const int hi = fq >> 1, jb = 8 * (fq & 1);
    const f32x4 c0 = *(const f32x4*)(cs + jb), c1 = *(const f32x4*)(cs + jb + 4);
    f32x4 s0 = *(const f32x4*)(sn + jb), s1 = *(const f32x4*)(sn + jb + 4);
    if (!hi) { s0 = -s0; s1 = -s1; }
    f32x4 o0, o1;
#pragma unroll
    for (int e = 0; e < 4; ++e) { o0[e] = xor32(v0[e], hi); o1[e] = xor32(v1[e], hi); }
    v0 = v0 * c0 + o0 * s0; v1 = v1 * c1 + o1 * s1;
}
template <int PH> DI void gemm_epi(const Params& p, const f32x4 (&acc)[2][2][4][2], const GUnit& u, int wr, int wc, int fr, int fq) {
    unsigned char* ws = p.ws;
    const int rbase = u.row0 + 64 * wr + fr, cbase = u.col0 + 32 * wc + (u.perm ? 8 : 4) * fq;
#define ST_PAIR(rowptr, bj, v0, v1) do { if (u.perm) st8((rowptr) + cbase + 128 * (bj), v0, v1); else { st4((rowptr) + cbase + 128 * (bj), v0); st4((rowptr) + cbase + 128 * (bj) + 16, v1); } } while (0)
    if (PH == 1) {
        if (u.kind == 1) {
            bf16_t* vt = (bf16_t*)(ws + OFF_VSBT);
#pragma unroll
            for (int ai = 0; ai < 2; ++ai)
#pragma unroll
                for (int m = 0; m < 4; ++m) { const int row = rbase + 128 * ai + 16 * m;
#pragma unroll
                    for (int bj = 0; bj < 2; ++bj) ST_PAIR(vt + (size_t)row * R, bj, acc[ai][bj][m][0], acc[ai][bj][m][1]); }
            return;
        }
        bf16_t* proj = (bf16_t*)(ws + OFF_PROJ);
        const float* cosT = (const float*)(ws + OFF_COS); const float* sinT = (const float*)(ws + OFF_SIN);
        const float qscale = (u.col0 < 512) ? QS64 : 1.f;
        const bool do_rope = (u.col0 == 2304) && (wc == 0);
#pragma unroll
        for (int ai = 0; ai < 2; ++ai)
#pragma unroll
            for (int m = 0; m < 4; ++m) {
                const int row = rbase + 128 * ai + 16 * m;
                f32x4 v[2][2];
#pragma unroll
                for (int bj = 0; bj < 2; ++bj)
#pragma unroll
                    for (int n = 0; n < 2; ++n) v[bj][n] = acc[ai][bj][m][n] * qscale;
                if (u.col0 == 2048) {
                    float s = 0.f;
#pragma unroll
                    for (int bj = 0; bj < 2; ++bj)
#pragma unroll
                        for (int n = 0; n < 2; ++n)
#pragma unroll
                            for (int e = 0; e < 4; ++e) s += v[bj][n][e] * v[bj][n][e];
                    s += __shfl_xor(s, 16); s += __shfl_xor(s, 32);
                    if (fq == 0) atomicAdd((float*)(ws + OFF_SSQ_Q) + row, s);
                }
                if (u.col0 == 2304) {
                    float s = 0.f;
#pragma unroll
                    for (int n = 0; n < 2; ++n)
#pragma unroll
                        for (int e = 0; e < 4; ++e) s += v[0][n][e] * v[0][n][e];
                    s += __shfl_xor(s, 16); s += __shfl_xor(s, 32);
                    if (fq == 0) atomicAdd((float*)(ws + OFF_SSQ_KV) + row, s);
                    if (do_rope) {
                        const int pos = 16 + (row & (SEQ - 1));
                        rope_perm(v[1][0], v[1][1], cosT + pos * 16, sinT + pos * 16, fq);
                    }
                }
#pragma unroll
                for (int bj = 0; bj < 2; ++bj) ST_PAIR(proj + (size_t)row * 3072, bj, v[bj][0], v[bj][1]);
            }
    } else if (PH == 2) {
        if (u.kind == 2) {
            bf16_t* vt = (bf16_t*)(ws + OFF_VMT); const float* ssq = (const float*)(ws + OFF_SSQ_KV);
            f32x4 rs[2][2];
#pragma unroll
            for (int bj = 0; bj < 2; ++bj)
#pragma unroll
                for (int n = 0; n < 2; ++n) { const f32x4 q = *(const f32x4*)(ssq + cbase + 128 * bj + (u.perm ? 4 : 16) * n);
#pragma unroll
                    for (int e = 0; e < 4; ++e) rs[bj][n][e] = rsqrtf(q[e] * (1.f / 128.f) + EPS); }
#pragma unroll
            for (int ai = 0; ai < 2; ++ai)
#pragma unroll
                for (int m = 0; m < 4; ++m) { const int row = rbase + 128 * ai + 16 * m;
#pragma unroll
                    for (int bj = 0; bj < 2; ++bj) ST_PAIR(vt + (size_t)row * R, bj, acc[ai][bj][m][0] * rs[bj][0], acc[ai][bj][m][1] * rs[bj][1]); }
            return;
        }
        const float* cosT = (const float*)(ws + OFF_COS); const float* sinT = (const float*)(ws + OFF_SIN);
        float rsv[2][4];
        { const float* ssq = (const float*)(ws + (u.kind == 0 ? OFF_SSQ_Q : OFF_SSQ_KV)); const float dinv = (u.kind == 0) ? (1.f / 256.f) : (1.f / 128.f), mul = (u.kind == 0) ? QS96 : 1.f;
          float raw[2][4];
#pragma unroll
          for (int ai = 0; ai < 2; ++ai)
#pragma unroll
              for (int m = 0; m < 4; ++m) raw[ai][m] = ssq[rbase + 128 * ai + 16 * m];
#pragma unroll
          for (int ai = 0; ai < 2; ++ai)
#pragma unroll
              for (int m = 0; m < 4; ++m) rsv[ai][m] = rsqrtf(raw[ai][m] * dinv + EPS) * mul; }
        if (u.kind == 0) {
            bf16_t* qm = (bf16_t*)(ws + OFF_QM);
            const bool rope0 = (((u.col0 >> 5) + wc) % 3 == 2), rope1 = (((u.col0 >> 5) + 4 + wc) % 3 == 2);
#pragma unroll
            for (int ai = 0; ai < 2; ++ai)
#pragma unroll
                for (int m = 0; m < 4; ++m) {
                    const int row = rbase + 128 * ai + 16 * m; const float rs = rsv[ai][m]; const int pos = 16 + (row & (SEQ - 1));
#pragma unroll
                    for (int bj = 0; bj < 2; ++bj) {
                        f32x4 v0 = acc[ai][bj][m][0] * rs, v1 = acc[ai][bj][m][1] * rs;
                        if (bj == 0 ? rope0 : rope1) rope_perm(v0, v1, cosT + pos * 16, sinT + pos * 16, fq);
                        ST_PAIR(qm + (size_t)row * 768, bj, v0, v1);
                    }
                }
        } else {
            bf16_t* km = (bf16_t*)(ws + OFF_KM);
#pragma unroll
            for (int ai = 0; ai < 2; ++ai)
#pragma unroll
                for (int m = 0; m < 4; ++m) { const int row = rbase + 128 * ai + 16 * m; const float rs = rsv[ai][m];
#pragma unroll
                    for (int bj = 0; bj < 2; ++bj) ST_PAIR(km + (size_t)row * 512, bj, acc[ai][bj][m][0] * rs, acc[ai][bj][m][1] * rs); }
        }
    } else if (PH == 4 || PH == 8) {
        bf16_t* dst = (bf16_t*)(ws + (PH == 4 ? OFF_D1 : OFF_D2));
#pragma unroll
        for (int ai = 0; ai < 2; ++ai)
#pragma unroll
            for (int m = 0; m < 4; ++m) { const int row = rbase + 128 * ai + 16 * m;
#pragma unroll
                for (int bj = 0; bj < 2; ++bj) ST_PAIR(dst + (size_t)row * 1024, bj, acc[ai][bj][m][0], acc[ai][bj][m][1]); }
    } else {
        bf16_t* dst = (bf16_t*)(ws + (u.kind == 1 ? OFF_VSBT : OFF_PROJ)); const size_t ld = (u.kind == 1) ? (size_t)R : (size_t)2304;
        const float qscale = (u.kind == 0 && u.col0 < 1024) ? QS64 : 1.f;
#pragma unroll
        for (int ai = 0; ai < 2; ++ai)
#pragma unroll
            for (int m = 0; m < 4; ++m) { const int row = rbase + 128 * ai + 16 * m;
#pragma unroll
                for (int bj = 0; bj < 2; ++bj) ST_PAIR(dst + (size_t)row * ld, bj, acc[ai][bj][m][0] * qscale, acc[ai][bj][m][1] * qscale); }
    }
#undef ST_PAIR
}

template <int PH>
DI void gemm_phase(const Params& p, LAS unsigned char* lds) {
    constexpr int K = PhCfg<PH>::K, nt = K / BK;
    const int tid = threadIdx.x, wid = __builtin_amdgcn_readfirstlane(tid >> 6), lane = tid & 63, wr = wid >> 2, wc = wid & 3, fr = lane & 15, fq = lane >> 4;
    int Rr[2], Rp[2], Cc2[2];
#pragma unroll
    for (int i = 0; i < 2; ++i) { int a, b; stage_rc(tid * 16 + i * 8192, a, b); Rr[i] = a; Rp[i] = (a & ~31) + perm32(a & 31); Cc2[i] = b * 2; }
    const size_t kstep = (size_t)(BK * 2);
    const unsigned ldsw = (unsigned)wid * 1024u;
    const int aoff = lds_byte(wr * 64 + fr, fq * 8), boff = lds_byte(wc * 32 + fr, fq * 8);
#define G_SA(b, h) (((b) * 2 + (h)) * HTB)
#define G_SB(b, h) ((4 + (b) * 2 + (h)) * HTB)
#define G_STAGEB(bufoff, gbase, ld, pf) do { _Pragma("unroll") for (int _i = 0; _i < 2; ++_i) \
        __builtin_amdgcn_global_load_lds((const unsigned*)((gbase) + (size_t)(((pf) ? Rp[_i] : Rr[_i]) * (ld) + Cc2[_i])), (LAS unsigned*)(lds + (bufoff) + ldsw + _i * 8192), 16, 0, 0); } while (0)
#define G_STAGE(bufoff, gbase, ld) do { _Pragma("unroll") for (int _i = 0; _i < 2; ++_i) \
        __builtin_amdgcn_global_load_lds((const unsigned*)((gbase) + (size_t)(Rr[_i] * (ld) + Cc2[_i])), (LAS unsigned*)(lds + (bufoff) + ldsw + _i * 8192), 16, 0, 0); } while (0)
#define G_LDA(dst, b, h) do { _Pragma("unroll") for (int m = 0; m < 4; ++m) _Pragma("unroll") for (int k = 0; k < 2; ++k) dst[m][k] = *(const LAS bf16x8*)(lds + G_SA(b, h) + aoff + m * 2048 + k * 1024); } while (0)
#define G_LDB(dst, b, h) do { _Pragma("unroll") for (int n = 0; n < 2; ++n) _Pragma("unroll") for (int k = 0; k < 2; ++k) dst[n][k] = *(const LAS bf16x8*)(lds + G_SB(b, h) + boff + n * 2048 + k * 1024); } while (0)
#define G_MMA(ai, bj, At, Bt) do { __builtin_amdgcn_s_setprio(1); _Pragma("unroll") for (int m = 0; m < 4; ++m) _Pragma("unroll") for (int n = 0; n < 2; ++n) _Pragma("unroll") for (int k = 0; k < 2; ++k) \
        acc[ai][bj][m][n] = __builtin_amdgcn_mfma_f32_16x16x32_bf16(Bt[n][k], At[m][k], acc[ai][bj][m][n], 0, 0, 0); __builtin_amdgcn_s_setprio(0); } while (0)
#define G_WAIT_V(n) asm volatile("s_waitcnt vmcnt(" #n ")" ::: "memory")
#define G_WAIT_L(n) asm volatile("s_waitcnt lgkmcnt(" #n ")" ::: "memory")
#define G_BAR __builtin_amdgcn_s_barrier()
#define G_SCHED __builtin_amdgcn_sched_barrier(0)
    GUnit cur, nxt; int ui = 0;
    if (!get_unit<PH>(p, 0, cur)) return;
    f32x4 acc[2][2][4][2];
#pragma unroll
    for (int a = 0; a < 2; ++a)
#pragma unroll
        for (int b = 0; b < 2; ++b)
#pragma unroll
            for (int m = 0; m < 4; ++m)
#pragma unroll
                for (int n = 0; n < 2; ++n) acc[a][b][m][n] = (f32x4){0.f, 0.f, 0.f, 0.f};
    bf16x8 At[4][2], B0[2][2], B1[2][2];
    const unsigned char* cA = cur.A; const unsigned char* cB = cur.B; int lda = cur.lda, ldb = cur.ldb; int pfc = cur.perm;
    {
        const size_t hA = (size_t)HALF * lda, hB = (size_t)HALF * ldb;
        G_STAGEB(G_SB(0, 0), cB, ldb, pfc); G_STAGE(G_SA(0, 0), cA, lda); G_STAGEB(G_SB(0, 1), cB + hB, ldb, pfc); G_STAGE(G_SA(0, 1), cA + hA, lda);
        if (wr == 1) G_BAR;
        G_WAIT_V(4); G_BAR;
        G_STAGEB(G_SB(1, 0), cB + kstep, ldb, pfc); G_STAGE(G_SA(1, 0), cA + kstep, lda); G_STAGEB(G_SB(1, 1), cB + hB + kstep, ldb, pfc);
        G_WAIT_V(6); G_BAR;
    }
    for (;;) {
        const bool has_next = get_unit<PH>(p, ui + 1, nxt);
        const unsigned char* nA = has_next ? nxt.A : cA; const unsigned char* nB = has_next ? nxt.B : cB;
        const int nlda = has_next ? nxt.lda : lda, nldb = has_next ? nxt.ldb : ldb, npf = has_next ? nxt.perm : pfc;
        _Pragma("unroll 1") for (int t = 0; t < nt; t += 2) {
            const bool last = (t == nt - 2);
            const unsigned char* a1 = cA + (size_t)(t + 1) * kstep;
            const unsigned char* a2 = last ? nA : cA + (size_t)(t + 2) * kstep; const unsigned char* b2 = last ? nB : cB + (size_t)(t + 2) * kstep;
            const int lda2 = last ? nlda : lda, ldb2 = last ? nldb : ldb, pf2 = last ? npf : pfc;
            const size_t hA1 = (size_t)HALF * lda, hA2 = (size_t)HALF * lda2, hB2 = (size_t)HALF * ldb2;
            const unsigned char* a3 = a2 + kstep; const unsigned char* b3 = b2 + kstep;
            G_LDB(B0, 0, 0); G_SCHED; G_LDA(At, 0, 0); G_STAGE(G_SA(1, 1), a1 + hA1, lda);
            G_WAIT_L(8); G_BAR; G_WAIT_L(0); G_MMA(0, 0, At, B0); G_BAR; G_SCHED;
            G_LDB(B1, 0, 1); G_STAGEB(G_SB(0, 0), b2, ldb2, pf2);
            G_BAR; G_WAIT_L(0); G_MMA(0, 1, At, B1); G_BAR;
            G_LDA(At, 0, 1); G_STAGE(G_SA(0, 0), a2, lda2);
            G_BAR; G_WAIT_L(0); G_MMA(1, 0, At, B0); G_BAR; G_SCHED;
            G_STAGEB(G_SB(0, 1), b2 + hB2, ldb2, pf2);
            G_WAIT_V(6); G_BAR; G_MMA(1, 1, At, B1); G_BAR;
            G_LDB(B0, 1, 0); G_SCHED; G_LDA(At, 1, 0); G_STAGE(G_SA(0, 1), a2 + hA2, lda2);
            G_WAIT_L(8); G_BAR; G_WAIT_L(0); G_MMA(0, 0, At, B0); G_BAR; G_SCHED;
            G_LDB(B1, 1, 1); G_STAGEB(G_SB(1, 0), b3, ldb2, pf2);
            G_BAR; G_WAIT_L(0); G_MMA(0, 1, At, B1); G_BAR;
            G_LDA(At, 1, 1); G_STAGE(G_SA(1, 0), a3, lda2);
            G_BAR; G_WAIT_L(0); G_MMA(1, 0, At, B0); G_BAR; G_SCHED;
            G_STAGEB(G_SB(1, 1), b3 + hB2, ldb2, pf2);
            G_WAIT_V(6); G_BAR; G_MMA(1, 1, At, B1); G_BAR;
        }
        gemm_epi<PH>(p, acc, cur, wr, wc, fr, fq);
        if (!has_next) break;
#pragma unroll
        for (int a = 0; a < 2; ++a)
#pragma unroll
            for (int b = 0; b < 2; ++b)
#pragma unroll
                for (int m = 0; m < 4; ++m)
#pragma unroll
                    for (int n = 0; n < 2; ++n) acc[a][b][m][n] = (f32x4){0.f, 0.f, 0.f, 0.f};
        cur = nxt; cA = nA; cB = nB; lda = nlda; ldb = nldb; pfc = npf; ++ui;
    }
    G_WAIT_V(0);
    if (wr == 0) G_BAR;
    G_BAR;
#undef G_SA
#undef G_SB
#undef G_STAGE
#undef G_STAGEB
#undef G_LDA
#undef G_LDB
#undef G_MMA
#undef G_WAIT_V
#undef G_WAIT_L
#undef G_BAR
#undef G_SCHED
}

DI void tiny_gemm(const bf16_t* A, int lda, const bf16_t* Bt, int ldb, int K, int cgp, int lane, int wid, LAS unsigned char* lds, f32x4& c0, f32x4& c1) {
    const int fr = lane & 15, fq = lane >> 4, kper = K >> 3;
    c0 = (f32x4){0.f, 0.f, 0.f, 0.f}; c1 = c0;
    const bf16_t* ap = A + (size_t)fr * lda + fq * 8 + wid * kper; const bf16_t* b0 = Bt + (size_t)(32 * cgp + fr) * ldb + fq * 8 + wid * kper; const bf16_t* b1 = b0 + (size_t)16 * ldb;
#pragma unroll 4
    for (int k = 0; k < kper; k += 32) {
        const bf16x8 a = *(const bf16x8*)(ap + k), x = *(const bf16x8*)(b0 + k), y = *(const bf16x8*)(b1 + k);
        c0 = __builtin_amdgcn_mfma_f32_16x16x32_bf16(a, x, c0, 0, 0, 0);
        c1 = __builtin_amdgcn_mfma_f32_16x16x32_bf16(a, y, c1, 0, 0, 0);
    }
    LAS f32x4* red = (LAS f32x4*)lds;
    red[(wid * 2 + 0) * 64 + lane] = c0; red[(wid * 2 + 1) * 64 + lane] = c1;
    __syncthreads();
    if (wid == 0) {
#pragma unroll
        for (int w = 1; w < 8; ++w) { c0 += red[(w * 2 + 0) * 64 + lane]; c1 += red[(w * 2 + 1) * 64 + lane]; }
    }
    __syncthreads();
}
DI float meta_rs(const bf16_t* src, int ld, int ncol, int lane) {
    const int row = lane & 15, part = lane >> 4, per = ncol / 4; float s = 0.f;
    const bf16_t* q = src + (size_t)row * ld + part * per;
    for (int k = 0; k < per; ++k) { const float v = __uint_as_float(((unsigned)q[k]) << 16); s += v * v; }
    s += __shfl_xor(s, 16); s += __shfl_xor(s, 32);
    return rsqrtf(s / (float)ncol + EPS);
}
DI unsigned short bf1(float x) { return (unsigned short)(pk2(x, 0.f) & 0xffffu); }

template <int PH> DI void meta_phase(const Params& p, LAS unsigned char* lds) {
    unsigned char* ws = p.ws;
    const int tid = threadIdx.x, wid = tid >> 6, lane = tid & 63, fr = lane & 15, fq = lane >> 4;
    const float* cosT = (const float*)(ws + OFF_COS); const float* sinT = (const float*)(ws + OFF_SIN);
    f32x4 c0, c1;
    if (PH == 1) {
        bf16_t* pm = (bf16_t*)(ws + OFF_PROJ_META); bf16_t* vt = (bf16_t*)(ws + OFF_VSBT_META);
        for (int u = blockIdx.x; u < 96; u += gridDim.x) {
            tiny_gemm((const bf16_t*)(ws + OFF_HN_META), 1024, (const bf16_t*)(ws + OFF_WT_IN0), 1024, 1024, u, lane, wid, lds, c0, c1);
            if (wid == 0) {
                if (u < 16) { c0 = c0 * QS64; c1 = c1 * QS64; }
                if (u == 76) {
#pragma unroll
                    for (int e = 0; e < 4; ++e) { const int m = 4 * fq + e; const float c = cosT[m * 16 + fr], s = sinT[m * 16 + fr]; const float x1 = c0[e], x2 = c1[e]; c0[e] = x1 * c - x2 * s; c1[e] = x1 * s + x2 * c; }
                }
#pragma unroll
                for (int e = 0; e < 4; ++e) { const int m = 4 * fq + e; const int col = 32 * u + fr;
                    const unsigned short h0 = bf1(c0[e]), h1 = bf1(c1[e]);
                    pm[m * 3072 + col] = h0; pm[m * 3072 + col + 16] = h1;
                    if (col >= 1024 && col < 1536) { vt[(col - 1024) * 16 + m] = h0; vt[(col - 1024 + 16) * 16 + m] = h1; } }
            }
        }
    } else if (PH == 2) {
        const bf16_t* pm = (const bf16_t*)(ws + OFF_PROJ_META);
        for (int u = blockIdx.x; u < 56; u += gridDim.x) {
            if (u < 24) {
                tiny_gemm(pm + 2048, 3072, (const bf16_t*)(ws + OFF_WT_UQ), 256, 256, u, lane, wid, lds, c0, c1);
                if (wid == 0) {
                    const float rsv = meta_rs(pm + 2048, 3072, 256, lane);
                    bf16_t* qm = (bf16_t*)(ws + OFF_QM_META);
#pragma unroll
                    for (int e = 0; e < 4; ++e) { const int m = 4 * fq + e; const float rs = __shfl(rsv, m) * QS96; float x1 = c0[e] * rs, x2 = c1[e] * rs;
                        if (u % 3 == 2) { const float c = cosT[m * 16 + fr], s = sinT[m * 16 + fr]; const float y1 = x1 * c - x2 * s, y2 = x1 * s + x2 * c; x1 = y1; x2 = y2; }
                        qm[m * 768 + 32 * u + fr] = bf1(x1); qm[m * 768 + 32 * u + 16 + fr] = bf1(x2); }
                }
            } else {
                const int isv = (u >= 40), uu = isv ? u - 40 : u - 24;
                tiny_gemm(pm + 2304, 3072, (const bf16_t*)(ws + (isv ? OFF_WT_UV : OFF_WT_UK)), 256, 256, uu, lane, wid, lds, c0, c1);
                if (wid == 0) {
                    const float rsv = meta_rs(pm + 2304, 3072, 128, lane);
#pragma unroll
                    for (int e = 0; e < 4; ++e) { const int m = 4 * fq + e; const float rs = __shfl(rsv, m); const int col = 32 * uu + fr;
                        const unsigned short h0 = bf1(c0[e] * rs), h1 = bf1(c1[e] * rs);
                        if (isv) { bf16_t* vt = (bf16_t*)(ws + OFF_VMT_META); vt[col * 16 + m] = h0; vt[(col + 16) * 16 + m] = h1; }
                        else { bf16_t* km = (bf16_t*)(ws + OFF_KM_META); km[m * 512 + col] = h0; km[m * 512 + col + 16] = h1; } }
                }
            }
        }
    } else if (PH == 4) {
        float* h1 = (float*)(ws + OFF_H1_META);
        for (int u = blockIdx.x; u < 32; u += gridDim.x) {
            tiny_gemm((const bf16_t*)(ws + OFF_AO_META), 1024, (const bf16_t*)(ws + OFF_WT_OUT0), 1024, 1024, u, lane, wid, lds, c0, c1);
            if (wid == 0) {
#pragma unroll
                for (int e = 0; e < 4; ++e) { const int m = 4 * fq + e; const int col = 32 * u + fr;
                    h1[m * 1024 + col] = p.meta[m * 1024 + col] + c0[e]; h1[m * 1024 + col + 16] = p.meta[m * 1024 + col + 16] + c1[e]; }
            }
        }
    } else if (PH == 6) {
        bf16_t* pm = (bf16_t*)(ws + OFF_PROJ_META); bf16_t* vt = (bf16_t*)(ws + OFF_VSBT_META);
        for (int u = blockIdx.x; u < 8; u += gridDim.x) {
            const int cgp = 32 + u;
            tiny_gemm((const bf16_t*)(ws + OFF_HN_META), 1024, (const bf16_t*)(ws + OFF_WT_IN1), 1024, 1024, cgp, lane, wid, lds, c0, c1);
            if (wid == 0) {
#pragma unroll
                for (int e = 0; e < 4; ++e) { const int m = 4 * fq + e; const int col = 32 * cgp + fr;
                    const unsigned short h0 = bf1(c0[e]), h1v = bf1(c1[e]);
                    pm[m * 2304 + col] = h0; pm[m * 2304 + col + 16] = h1v;
                    vt[(col - 1024) * 16 + m] = h0; vt[(col - 1024 + 16) * 16 + m] = h1v; }
            }
        }
    }
}

DI void transpose_item(const float* W, int ldw, int Kv, int Nv, int k0, int n0, const float* gain, bf16_t* dst, int ldd, int drow0, int dcol0, LAS float* scr, int lane) {
    const int n = n0 + (lane & 31);
#pragma unroll 8
    for (int i = 0; i < 32; ++i) { const int kk = 2 * i + (lane >> 5), k = k0 + kk;
        float v = 0.f; if (k < Kv && n < Nv) { v = W[(size_t)k * ldw + n]; if (gain) v *= gain[k]; }
        scr[kk * 33 + (lane & 31)] = v; }
    asm volatile("s_waitcnt lgkmcnt(0)" ::: "memory");
    const int c = lane & 7;
#pragma unroll
    for (int j = 0; j < 4; ++j) { const int nn = (lane >> 3) + 8 * j; const LAS float* q = scr + (8 * c) * 33 + nn;
        u32x4 o; o.x = pk2(q[0 * 33], q[1 * 33]); o.y = pk2(q[2 * 33], q[3 * 33]); o.z = pk2(q[4 * 33], q[5 * 33]); o.w = pk2(q[6 * 33], q[7 * 33]);
        *(u32x4*)(dst + (size_t)(drow0 + nn) * ldd + dcol0 + 8 * c) = o; }
    asm volatile("s_waitcnt lgkmcnt(0)" ::: "memory");
}
DI void load_row(const float* x, const bf16_t* da, const bf16_t* db, int lane, f32x4 (&v)[4]) {
#pragma unroll
    for (int j = 0; j < 4; ++j) v[j] = ((const f32x4*)x)[lane + 64 * j];
    if (da) {
#pragma unroll
        for (int j = 0; j < 4; ++j) { const u32x2 q = ((const u32x2*)da)[lane + 64 * j]; v[j][0] += bflo(q.x); v[j][1] += bfhi(q.x); v[j][2] += bflo(q.y); v[j][3] += bfhi(q.y); }
    }
    if (db) {
#pragma unroll
        for (int j = 0; j < 4; ++j) { const u32x2 q = ((const u32x2*)db)[lane + 64 * j]; v[j][0] += bflo(q.x); v[j][1] += bfhi(q.x); v[j][2] += bflo(q.y); v[j][3] += bfhi(q.y); }
    }
}
DI float row_ssq(const f32x4 (&v)[4]) { float s = 0.f;
#pragma unroll
    for (int j = 0; j < 4; ++j) s += v[j][0] * v[j][0] + v[j][1] * v[j][1] + v[j][2] * v[j][2] + v[j][3] * v[j][3];
    return s; }
DI void norm_rows_bf16(const float* x, const bf16_t* da, size_t r0, size_t r1, bool two, const float* g, bf16_t* dst, int lane) {
    f32x4 v[4], w[4];
    load_row(x + r0 * 1024, da ? da + r0 * 1024 : nullptr, nullptr, lane, v);
    if (two) load_row(x + r1 * 1024, da ? da + r1 * 1024 : nullptr, nullptr, lane, w);
    else {
#pragma unroll
        for (int j = 0; j < 4; ++j) w[j] = (f32x4){0.f, 0.f, 0.f, 0.f};
    }
    const float rs = rsqrtf(wave_sum(row_ssq(v)) * (1.f / 1024.f) + EPS), rt = rsqrtf(wave_sum(row_ssq(w)) * (1.f / 1024.f) + EPS);
#pragma unroll
    for (int j = 0; j < 4; ++j) { const f32x4 gg = ((const f32x4*)g)[lane + 64 * j]; st4(dst + r0 * 1024 + 4 * (lane + 64 * j), v[j] * rs * gg); if (two) st4(dst + r1 * 1024 + 4 * (lane + 64 * j), w[j] * rt * gg); }
}
DI void norm_rows_f32(const float* x, const bf16_t* da, const bf16_t* db, size_t r0, size_t r1, bool two, const float* g, float* out, int lane) {
    f32x4 v[4], w[4];
    load_row(x + r0 * 1024, da + r0 * 1024, db + r0 * 1024, lane, v);
    if (two) load_row(x + r1 * 1024, da + r1 * 1024, db + r1 * 1024, lane, w);
    else {
#pragma unroll
        for (int j = 0; j < 4; ++j) w[j] = (f32x4){0.f, 0.f, 0.f, 0.f};
    }
    const float rs = rsqrtf(wave_sum(row_ssq(v)) * (1.f / 1024.f) + EPS), rt = rsqrtf(wave_sum(row_ssq(w)) * (1.f / 1024.f) + EPS);
#pragma unroll
    for (int j = 0; j < 4; ++j) { const f32x4 gg = ((const f32x4*)g)[lane + 64 * j]; ((f32x4*)(out + r0 * 1024))[lane + 64 * j] = v[j] * rs * gg; if (two) ((f32x4*)(out + r1 * 1024))[lane + 64 * j] = w[j] * rt * gg; }
}

constexpr int WJ_EARLY = 16 * 96 + 4 * 24 + 4 * 32, WJ_ALL = WJ_EARLY + 16 * 32 + 16 * 72 + 16 * 32;
DI void weight_jobs(const Params& p, LAS unsigned char* lds, int lo, int hi, int w0, int wstride) {
    unsigned char* ws = p.ws; const int wid = threadIdx.x >> 6, lane = threadIdx.x & 63;
    constexpr int J1 = 16 * 96, J2 = 4 * 24, J3 = 4 * 32, J4 = 16 * 32, J5 = 16 * 72;
    LAS float* scr = (LAS float*)(lds + wid * 8448);
    for (int job = lo + w0; job < hi; job += wstride) {
        int r = job;
        if (r < J1) { const int nt_ = r / 16, kt = r % 16; transpose_item(p.ev_w_in, 2976, 1024, 2976, kt * 64, nt_ * 32, nullptr, (bf16_t*)(ws + OFF_WT_IN0), 1024, nt_ * 32, kt * 64, scr, lane); continue; } r -= J1;
        if (r < J2) { const int nt_ = r / 4, kt = r % 4; transpose_item(p.ev_w_uq, 768, 256, 768, kt * 64, nt_ * 32, p.ev_qg, (bf16_t*)(ws + OFF_WT_UQ), 256, nt_ * 32, kt * 64, scr, lane); continue; } r -= J2;
        if (r < J3) { const int nts = r / 4, kt = r % 4;
            transpose_item(p.ev_w_ukv, 1024, 128, 1024, kt * 64, nts * 32, p.ev_kvg, (bf16_t*)(ws + (((nts >> 1) & 1) ? OFF_WT_UV : OFF_WT_UK)), 256, (nts >> 2) * 64 + (nts & 1) * 32, kt * 64, scr, lane); continue; } r -= J3;
        if (r < J4) { const int nt_ = r / 16, kt = r % 16; transpose_item(p.ev_w_out, 1024, 1024, 1024, kt * 64, nt_ * 32, nullptr, (bf16_t*)(ws + OFF_WT_OUT0), 1024, nt_ * 32, kt * 64, scr, lane); continue; } r -= J4;
        if (r < J5) { const int nt_ = r / 16, kt = r % 16; transpose_item(p.od_w_in, 2304, 1024, 2304, kt * 64, nt_ * 32, nullptr, (bf16_t*)(ws + OFF_WT_IN1), 1024, nt_ * 32, kt * 64, scr, lane); continue; } r -= J5;
        { const int nt_ = r / 16, kt = r % 16; transpose_item(p.od_w_out, 1024, 1024, 1024, kt * 64, nt_ * 32, nullptr, (bf16_t*)(ws + OFF_WT_OUT1), 1024, nt_ * 32, kt * 64, scr, lane); }
    }
}
DI void prep_phase(const Params& p, LAS unsigned char* lds) {
    unsigned char* ws = p.ws;
    const int tid = threadIdx.x, wid = tid >> 6, lane = tid & 63;
    weight_jobs(p, lds, 0, WJ_EARLY, blockIdx.x * 8 + wid, gridDim.x * 8);
    const int gtid = blockIdx.x * 512 + tid, ngt = gridDim.x * 512;
    for (int i = gtid; i < R; i += ngt) { ((float*)(ws + OFF_SSQ_Q))[i] = 0.f; ((float*)(ws + OFF_SSQ_KV))[i] = 0.f; }
    for (int i = gtid; i < 2064 * 16; i += ngt) {
        const int pos = i >> 4, j = i & 15;
        double inv = 1.0; { const int jq = j >> 2, jr = j & 3; for (int q = 0; q < jq; ++q) inv *= 0.1; inv *= (jr == 0 ? 1.0 : jr == 1 ? 0.5623413251903491 : jr == 2 ? 0.31622776601683794 : 0.1778279410038923); }
        double ang = (double)pos * inv; const double TWO_PI = 6.283185307179586476925;
        ang -= TWO_PI * __builtin_rint(ang * (1.0 / TWO_PI));
        const double x2 = ang * ang; double sn = 0.0, cs = 0.0, ts = ang, tc = 1.0;
        for (int k = 0; k < 16; ++k) { sn += ts; cs += tc; tc *= -x2 / (double)((2 * k + 1) * (2 * k + 2)); ts *= -x2 / (double)((2 * k + 2) * (2 * k + 3)); }
        ((float*)(ws + OFF_COS))[i] = (float)cs; ((float*)(ws + OFF_SIN))[i] = (float)sn;
    }
    const int gw = blockIdx.x * 8 + wid, ngw = gridDim.x * 8;
    for (int row = gw; row < R; row += 2 * ngw) { const int r1 = row + ngw; const bool two = r1 < R;
        norm_rows_bf16(p.x, nullptr, (size_t)row, (size_t)(two ? r1 : row), two, p.norm_g, (bf16_t*)(ws + OFF_HN), lane); }
    for (int row = gw; row < NMETA; row += ngw) norm_rows_bf16(p.meta, nullptr, (size_t)row, (size_t)row, false, p.norm_g, (bf16_t*)(ws + OFF_HN_META), lane);
}

DI f32x16 mfma32(bf16x8 a, bf16x8 b, f32x16 c) { return __builtin_amdgcn_mfma_f32_32x32x16_bf16(a, b, c, 0, 0, 0); }
constexpr int VSTR = 72;

template <int NKS, int KSTR>
DI void k_frags(LAS const unsigned char* kt, int sub, int ql, int hf, bf16x8 (&kf)[NKS]) {
    LAS const unsigned char* kp = kt + (32 * sub + ql) * (KSTR * 2) + hf * 16;
#pragma unroll
    for (int ks = 0; ks < NKS; ++ks) kf[ks] = *(LAS const bf16x8*)(kp + ks * 32);
}
template <int NKS>
DI f32x16 qk_mma(const bf16x8 (&kf)[NKS], const bf16x8 (&qf)[NKS], f32x16 s) {
#pragma unroll
    for (int ks = 0; ks < NKS; ++ks) s = mfma32(kf[ks], qf[ks], s);
    return s;
}
template <int VSB>
DI void v_frags(LAS const unsigned char* vt, int sub, int ql, int hf, bf16x8 (&vf)[2][2]) {
#pragma unroll
    for (int s2 = 0; s2 < 2; ++s2)
#pragma unroll
        for (int dt = 0; dt < 2; ++dt) vf[s2][dt] = *(LAS const bf16x8*)(vt + (32 * dt + ql) * VSB + (2 * sub + s2) * 32 + hf * 16);
}
DI void pv_mma(const bf16x8 (&vf)[2][2], const f32x16& pr, f32x16 (&O)[2]) {
#pragma unroll
    for (int s2 = 0; s2 < 2; ++s2) {
        u32x4 pp; pp.x = pk2(pr[8 * s2 + 0], pr[8 * s2 + 1]); pp.y = pk2(pr[8 * s2 + 2], pr[8 * s2 + 3]); pp.z = pk2(pr[8 * s2 + 4], pr[8 * s2 + 5]); pp.w = pk2(pr[8 * s2 + 6], pr[8 * s2 + 7]);
        const bf16x8 pf = __builtin_bit_cast(bf16x8, pp);
#pragma unroll
        for (int dt = 0; dt < 2; ++dt) O[dt] = mfma32(vf[s2][dt], pf, O[dt]);
    }
}
DI void vt_store(LAS unsigned char* rowp, int c, u32x4 v) {
    LAS unsigned char* q = rowp + 32 * (c >> 1) + 8 * (c & 1);
    u32x2 lo; lo.x = v.x; lo.y = v.y; u32x2 hi; hi.x = v.z; hi.y = v.w;
    *(LAS u32x2*)q = lo; *(LAS u32x2*)(q + 16) = hi;
}
DI f32x16 splat16(float v) { f32x16 s;
#pragma unroll
    for (int i = 0; i < 16; ++i) s[i] = v;
    return s; }
constexpr float SM_TAU = 8.f;
DI void softmax_update(f32x16 (&s)[2], const bool (&have)[2], bool first, int hf, float& mrun, float& lpart, f32x16 (&O)[2]) {
    int im = (int)0x80000000;
#pragma unroll
    for (int t = 0; t < 2; ++t) if (have[t]) {
#pragma unroll
        for (int i = 0; i < 16; i += 2) { const int a = (int)__float_as_uint(s[t][i]), b = (int)__float_as_uint(s[t][i + 1]); const int m2 = a > b ? a : b; im = im > m2 ? im : m2; }
    }
    if (first || __any(__uint_as_float((unsigned)im) > SM_TAU)) {
        float mx = -1e30f;
#pragma unroll
        for (int t = 0; t < 2; ++t) if (have[t]) {
#pragma unroll
            for (int i = 0; i < 16; ++i) mx = __builtin_fmaxf(mx, s[t][i]);
        }
        mx = __builtin_fmaxf(mx, xor32(mx, hf));
        const float d = first ? mx : __builtin_fmaxf(mx, 0.f);
        const float alpha = fexp2(-d);
        mrun += d; lpart *= alpha;
#pragma unroll
        for (int i = 0; i < 16; ++i) { O[0][i] *= alpha; O[1][i] *= alpha; }
#pragma unroll
        for (int t = 0; t < 2; ++t) if (have[t]) {
#pragma unroll
            for (int i = 0; i < 16; ++i) s[t][i] -= d;
        }
    }
    f32x2_t ps = {0.f, 0.f};
#pragma unroll
    for (int t = 0; t < 2; ++t) if (have[t]) {
#pragma unroll
        for (int i = 0; i < 16; i += 2) { f32x2_t e; e[0] = fexp2(s[t][i]); e[1] = fexp2(s[t][i + 1]); s[t][i] = e[0]; s[t][i + 1] = e[1]; ps += e; }
    }
    lpart += ps[0] + ps[1];
}
DI void attn_store(const f32x16 (&O)[2], float inv, const u32x4 (&gq)[4], bf16_t* orow, int hf) {
#pragma unroll
    for (int dt = 0; dt < 2; ++dt)
#pragma unroll
        for (int ap = 0; ap < 2; ++ap) {
            float A[4], B[4];
#pragma unroll
            for (int e = 0; e < 4; ++e) {
                const unsigned a = __float_as_uint(O[dt][8 * ap + e] * inv), b = __float_as_uint(O[dt][8 * ap + 4 + e] * inv);
                auto r = __builtin_amdgcn_permlane32_swap(a, b, false, false);
                A[e] = __uint_as_float(r[0]); B[e] = __uint_as_float(r[1]);
            }
            const u32x4 g = gq[2 * dt + ap];
            const float g0 = bflo(g.x), g1 = bfhi(g.x), g2 = bflo(g.y), g3 = bfhi(g.y), g4 = bflo(g.z), g5 = bfhi(g.z), g6 = bflo(g.w), g7 = bfhi(g.w);
            f32x4 lo, hi;
            lo[0] = A[0] * g0 * __builtin_amdgcn_rcpf(1.f + __expf(-g0)); lo[1] = A[1] * g1 * __builtin_amdgcn_rcpf(1.f + __expf(-g1));
            lo[2] = A[2] * g2 * __builtin_amdgcn_rcpf(1.f + __expf(-g2)); lo[3] = A[3] * g3 * __builtin_amdgcn_rcpf(1.f + __expf(-g3));
            hi[0] = B[0] * g4 * __builtin_amdgcn_rcpf(1.f + __expf(-g4)); hi[1] = B[1] * g5 * __builtin_amdgcn_rcpf(1.f + __expf(-g5));
            hi[2] = B[2] * g6 * __builtin_amdgcn_rcpf(1.f + __expf(-g6)); hi[3] = B[3] * g7 * __builtin_amdgcn_rcpf(1.f + __expf(-g7));
            st8(orow + 32 * dt + 16 * ap + 8 * hf, lo, hi);
        }
}

template <bool MASK>
DI void sb_math(const f32x16& s, int limh, int hf, float& carry, f32x16& pr) {
    f32x16 lg, n1;
#pragma unroll
    for (int i = 0; i < 16; ++i) {
        const float z = __builtin_amdgcn_fmed3f(s[i], -100.f, 100.f);
        const float l = flog2(1.f + fexp2(-z));
        if (MASK) { const bool vis = ((8 * (i >> 2) + (i & 3)) < limh); lg[i] = vis ? l : 1e30f; n1[i] = vis ? (l + z) : 0.f; }
        else { lg[i] = l; n1[i] = l + z; }
    }
    float gs[4], og[4];
#pragma unroll
    for (int a = 0; a < 4; ++a) { gs[a] = (n1[4 * a] + n1[4 * a + 1]) + (n1[4 * a + 2] + n1[4 * a + 3]); og[a] = xor32(gs[a], hf); }
    float run = carry;
#pragma unroll
    for (int a = 3; a >= 0; --a) {
        float t = run + (hf ? 0.f : og[a]);
        pr[4 * a + 3] = fexp2(-(lg[4 * a + 3] + t)); t += n1[4 * a + 3];
        pr[4 * a + 2] = fexp2(-(lg[4 * a + 2] + t)); t += n1[4 * a + 2];
        pr[4 * a + 1] = fexp2(-(lg[4 * a + 1] + t)); t += n1[4 * a + 1];
        pr[4 * a + 0] = fexp2(-(lg[4 * a + 0] + t));
        run += gs[a] + og[a];
    }
    carry = run;
}

template <int MODE>
DI void attn_item(const Params& p, LAS unsigned char* lds, int b, int h, int qb, bool metaq) {
    constexpr int DK = (MODE == 1) ? 96 : 64, KSTR = DK + 8, NKS = DK / 16;
    constexpr int KBYTES = 64 * KSTR * 2, VBYTES = 64 * VSTR * 2, BUF = KBYTES + VBYTES;
    unsigned char* ws = p.ws;
    const int tid = threadIdx.x, wid = __builtin_amdgcn_readfirstlane(tid >> 6), lane = tid & 63, ql = lane & 31, hf = lane >> 5;
    const int ldp = (MODE == 2) ? 2304 : 3072;
    const bf16_t* proj = (const bf16_t*)(ws + OFF_PROJ); const bf16_t* projm = (const bf16_t*)(ws + OFF_PROJ_META);
    const bf16_t *Kreal, *Kmeta, *Krreal = nullptr, *Krmeta = nullptr, *Vtreal, *Vtmeta; int ldk;
    if (MODE == 0) { Kreal = proj + (size_t)b * SEQ * 3072 + 512 + h * 64; Kmeta = projm + 512 + h * 64; ldk = 3072;
        Vtreal = (const bf16_t*)(ws + OFF_VSBT) + (size_t)(h * 64) * R + b * SEQ; Vtmeta = (const bf16_t*)(ws + OFF_VSBT_META) + h * 64 * 16; }
    else if (MODE == 1) { Kreal = (const bf16_t*)(ws + OFF_KM) + (size_t)b * SEQ * 512 + h * 64; Kmeta = (const bf16_t*)(ws + OFF_KM_META) + h * 64; ldk = 512;
        Krreal = proj + (size_t)b * SEQ * 3072 + 2432; Krmeta = projm + 2432;
        Vtreal = (const bf16_t*)(ws + OFF_VMT) + (size_t)(h * 64) * R + b * SEQ; Vtmeta = (const bf16_t*)(ws + OFF_VMT_META) + h * 64 * 16; }
    else { Kreal = proj + (size_t)b * SEQ * 2304 + 1024 + h * 64; Kmeta = projm + 1024 + h * 64; ldk = 2304;
        Vtreal = (const bf16_t*)(ws + OFF_VSBT) + (size_t)(128 + h * 64) * R + b * SEQ; Vtmeta = (const bf16_t*)(ws + OFF_VSBT_META) + (128 + h * 64) * 16; }
    const int head = (MODE == 2) ? h * 8 + wid : h;
    int qrow;
    bool wactive = true;
    if (MODE == 2) qrow = 32 * qb + ql;
    else if (metaq) { qrow = (ql < 16) ? ql : 15; wactive = (wid == 0); }
    else qrow = 256 * qb + 32 * wid + ql;
    const bf16_t* qptr;
    if (MODE == 0) qptr = metaq ? projm + (size_t)qrow * 3072 + h * 64 : proj + ((size_t)b * SEQ + qrow) * 3072 + h * 64;
    else if (MODE == 1) qptr = metaq ? (const bf16_t*)(ws + OFF_QM_META) + (size_t)qrow * 768 + h * 96 : (const bf16_t*)(ws + OFF_QM) + ((size_t)b * SEQ + qrow) * 768 + h * 96;
    else qptr = proj + ((size_t)b * SEQ + qrow) * 2304 + head * 64;
    bf16x8 qf[NKS];
#pragma unroll
    for (int ks = 0; ks < NKS; ++ks) qf[ks] = *(const bf16x8*)(qptr + 16 * ks + 8 * hf);
    int T, ntiles, t0 = 0;
    if (MODE == 2) { const int lo = 32 * qb - 127; t0 = (lo > 0 ? lo : 0) >> 6; T = (qb >> 1) - t0 + 1; ntiles = T + 1; }
    else { T = metaq ? 0 : 4 * (qb + 1); ntiles = T + 1; }
#define TILE_OF(j, ism, key0) do { if (MODE == 0) { ism = ((j) >= T); key0 = 64 * (T - 1 - (j)); } else if (MODE == 1) { ism = ((j) == 0); key0 = 64 * ((j) - 1); } else { ism = ((j) == 0); key0 = 64 * (t0 + (j) - 1); } } while (0)
    u32x4 kreg, krreg, vreg;
    krreg = (u32x4){0u, 0u, 0u, 0u};
#define ISSUE(j) do { bool ism_; int key0_; TILE_OF(j, ism_, key0_); \
        { const int row = tid >> 3, ch = tid & 7; const int rr = ism_ ? (row < 16 ? row : 15) : key0_ + row; kreg = *(const u32x4*)((ism_ ? Kmeta : Kreal) + (size_t)rr * ldk + ch * 8); } \
        if (MODE == 1) { if (tid < 256) { const int row = tid >> 2, ch = tid & 3; const int rr = ism_ ? (row < 16 ? row : 15) : key0_ + row; krreg = *(const u32x4*)((ism_ ? Krmeta : Krreal) + (size_t)rr * 3072 + ch * 8); } } \
        { const int d = tid >> 3, ch = tid & 7; \
          if (ism_) { vreg = (u32x4){0u, 0u, 0u, 0u}; if (ch < 2) vreg = *(const u32x4*)(Vtmeta + d * 16 + ch * 8); } \
          else vreg = *(const u32x4*)(Vtreal + (size_t)d * R + key0_ + ch * 8); } } while (0)
#define STASH(buf) do { LAS unsigned char* kb_ = lds + (buf) * BUF; LAS unsigned char* vb_ = kb_ + KBYTES; \
        *(LAS u32x4*)(kb_ + (tid >> 3) * (KSTR * 2) + (tid & 7) * 16) = kreg; \
        if (MODE == 1) { if (tid < 256) *(LAS u32x4*)(kb_ + (tid >> 2) * (KSTR * 2) + 128 + (tid & 3) * 16) = krreg; } \
        vt_store(vb_ + (tid >> 3) * (VSTR * 2), tid & 7, vreg); } while (0)

    f32x16 O[2];
#pragma unroll
    for (int i = 0; i < 16; ++i) { O[0][i] = 0.f; O[1][i] = 0.f; }
    float carry = 0.f;
    float mrun = 0.f, lpart = 0.f;
    bool sm_first = true;


    bool wdone = !wactive;
    LAS int* flags = (LAS int*)(lds + 65536);
    ISSUE(0); STASH(0); __syncthreads();
    for (int j = 0; j < ntiles; ++j) {
        if (j + 1 < ntiles) ISSUE(j + 1);
        bool ism; int key0; TILE_OF(j, ism, key0);
        LAS const unsigned char* kt = lds + (j & 1) * BUF; LAS const unsigned char* vt = kt + KBYTES;
        if (wactive && !wdone) {
            if (MODE == 0) {
#pragma unroll
                for (int sb = 1; sb >= 0; --sb) {
                    int lim; bool needmask = true;
                    if (ism) { if (sb == 1) continue; lim = metaq ? (ql < 16 ? ql : 16) : 16; }
                    else { const int rel = (key0 >> 5) + sb - (8 * qb + wid); if (rel > 0) continue; lim = (rel == 0) ? ql : 64; needmask = (rel == 0); }
                    const int limh = lim - 4 * hf;
                    bf16x8 kf[NKS], vf[2][2];
                    k_frags<NKS, KSTR>(kt, sb, ql, hf, kf);
                    __builtin_amdgcn_sched_barrier(0);
                    const f32x16 s = qk_mma<NKS>(kf, qf, splat16(0.f));
                    f32x16 pr;
                    if (needmask) sb_math<true>(s, limh, hf, carry, pr); else sb_math<false>(s, limh, hf, carry, pr);
                    v_frags<VSTR * 2>(vt, sb, ql, hf, vf);
                    pv_mma(vf, pr, O);
                }
            } else {
                f32x16 s[2]; bool have[2], needmask[2]; int hi[2];
#pragma unroll
                for (int sb = 0; sb < 2; ++sb) {
                    have[sb] = true; needmask[sb] = true;
                    if (ism) { if (sb == 1) have[sb] = false; hi[sb] = (metaq ? (ql + 1 < 16 ? ql + 1 : 16) : 16) - 4 * hf - 1; }
                    else { const int rel = (key0 >> 5) + sb - (8 * qb + wid); if (rel > 0) have[sb] = false; hi[sb] = ((rel == 0) ? ql + 1 : 64) - 4 * hf - 1; needmask[sb] = (rel == 0); }
                }
                if (have[0] || have[1]) {
                    bf16x8 kf[NKS], vf0[2][2], vf1[2][2];
                    if (have[0]) { k_frags<NKS, KSTR>(kt, 0, ql, hf, kf);
                        __builtin_amdgcn_sched_barrier(0);
                        s[0] = qk_mma<NKS>(kf, qf, splat16(-mrun)); }
                    if (have[1]) { k_frags<NKS, KSTR>(kt, 1, ql, hf, kf);
                        __builtin_amdgcn_sched_barrier(0);
                        s[1] = qk_mma<NKS>(kf, qf, splat16(-mrun)); }
                    if (have[0]) v_frags<VSTR * 2>(vt, 0, ql, hf, vf0);
                    if (have[1]) v_frags<VSTR * 2>(vt, 1, ql, hf, vf1);
                    __builtin_amdgcn_sched_barrier(0);
#pragma unroll
                    for (int sb = 0; sb < 2; ++sb) if (have[sb] && needmask[sb]) {
#pragma unroll
                        for (int i = 0; i < 16; ++i) { const int cst = 8 * (i >> 2) + (i & 3); s[sb][i] = (cst <= hi[sb]) ? s[sb][i] : -1e30f; }
                    }
                    softmax_update(s, have, sm_first, hf, mrun, lpart, O); sm_first = false;
                    if (have[0]) pv_mma(vf0, s[0], O);
                    if (have[1]) pv_mma(vf1, s[1], O);
                }
            }
        }
        if (MODE == 0) {
            if (!wdone) wdone = __all(carry > -SB_THRESH);
            if (lane == 0) flags[(j & 1) * 8 + wid] = wdone ? 1 : 0;
        }
        if (j + 1 < ntiles) STASH((j + 1) & 1);
        __syncthreads();
        if (MODE == 0) {
            int alld = 1;
#pragma unroll
            for (int w = 0; w < 8; ++w) alld &= flags[(j & 1) * 8 + w];
            if (alld) break;
        }
    }
#undef TILE_OF
#undef ISSUE
#undef STASH
    int qrow_e = qrow; asm volatile("" : "+v"(qrow_e));
    if (wactive && (!metaq || ql < 16)) {
        float inv = 1.f;
        if (MODE != 0) { const float l = lpart + xor32(lpart, hf); inv = 1.f / l; }
        const bf16_t* gptr; bf16_t* optr;
        if (MODE == 0) { gptr = metaq ? projm + (size_t)qrow_e * 3072 + 1536 + h * 64 : proj + ((size_t)b * SEQ + qrow_e) * 3072 + 1536 + h * 64;
            optr = metaq ? (bf16_t*)(ws + OFF_AO_META) + (size_t)qrow_e * 1024 + h * 64 : (bf16_t*)(ws + OFF_HN) + ((size_t)b * SEQ + qrow_e) * 1024 + h * 64; }
        else if (MODE == 1) { gptr = metaq ? projm + (size_t)qrow_e * 3072 + 2464 + h * 64 : proj + ((size_t)b * SEQ + qrow_e) * 3072 + 2464 + h * 64;
            optr = metaq ? (bf16_t*)(ws + OFF_AO_META) + (size_t)qrow_e * 1024 + 512 + h * 64 : (bf16_t*)(ws + OFF_HN) + ((size_t)b * SEQ + qrow_e) * 1024 + 512 + h * 64; }
        else { gptr = proj + ((size_t)b * SEQ + qrow_e) * 2304 + 1280 + head * 64; optr = (bf16_t*)(ws + OFF_HN) + ((size_t)b * SEQ + qrow_e) * 1024 + head * 64; }
        u32x4 gq4[4];
#pragma unroll
        for (int k = 0; k < 4; ++k) gq4[k] = *(const u32x4*)(gptr + 16 * k + 8 * hf);
        attn_store(O, inv, gq4, optr, hf);
    }
}

DI void attn0_phase(const Params& p, LAS unsigned char* lds) {
    for (int it = blockIdx.x; it < 2048 + 16; it += gridDim.x) {
        if (it < 2048) {
            const int j = it >> 8, c = it & 255, b = c >> 4, h = (c & 15) >> 1, st = c & 1, type = j & 1, qi = j >> 1;
            const int sel = type ? st : 1 - st;
            const int qb = sel ? (qi == 0 ? 6 : qi == 1 ? 5 : qi == 2 ? 2 : 1) : (qi == 0 ? 7 : qi == 1 ? 4 : qi == 2 ? 3 : 0);
            if (type == 0) attn_item<0>(p, lds, b, h, qb, false); else attn_item<1>(p, lds, b, h, qb, false);
        } else { const int hh = it - 2048; if (hh < 8) attn_item<0>(p, lds, 0, hh, 0, true); else attn_item<1>(p, lds, 0, hh - 8, 0, true); }
    }
}
struct SwaRegs { u32x4 kr[4], vr[4], mr; };
DI void swa_load(const Params& p, int b, int kvh, int I, SwaRegs& g) {
    unsigned char* ws = p.ws; const int tid = threadIdx.x;
    const bf16_t* proj = (const bf16_t*)(ws + OFF_PROJ); const bf16_t* projm = (const bf16_t*)(ws + OFF_PROJ_META);
    const int kb = 128 * I - 128;
    const bf16_t* Kreal = proj + (size_t)b * SEQ * 2304 + 1024 + kvh * 64; const bf16_t* Kmeta = projm + 1024 + kvh * 64;
    const bf16_t* Vtreal = (const bf16_t*)(ws + OFF_VSBT) + (size_t)(128 + kvh * 64) * R + b * SEQ; const bf16_t* Vtmeta = (const bf16_t*)(ws + OFF_VSBT_META) + (128 + kvh * 64) * 16;
    g.mr = (u32x4){0u, 0u, 0u, 0u};
#pragma unroll
    for (int i = 0; i < 4; ++i) { const int c = tid + 512 * i, row = c >> 3, ch = c & 7, key = kb + row;
        g.kr[i] = (u32x4){0u, 0u, 0u, 0u}; if (key >= 0) g.kr[i] = *(const u32x4*)(Kreal + (size_t)key * 2304 + ch * 8); }
#pragma unroll
    for (int i = 0; i < 4; ++i) { const int c = tid + 512 * i, d = c >> 5, ch = c & 31, key = kb + 8 * ch;
        g.vr[i] = (u32x4){0u, 0u, 0u, 0u}; if (key >= 0) g.vr[i] = *(const u32x4*)(Vtreal + (size_t)d * R + key); }
    if (tid < 128) { const int row = tid >> 3, ch = tid & 7; g.mr = *(const u32x4*)(Kmeta + row * 2304 + ch * 8); }
    else if (tid < 256) { const int t = tid - 128, d = t >> 1, ch = t & 1; g.mr = *(const u32x4*)(Vtmeta + d * 16 + ch * 8); }
}
DI void swa_stash(LAS unsigned char* lds, const SwaRegs& g) {
    constexpr int KSB = 144, VSB = 592, KBYTES = 288 * KSB;
    const int tid = threadIdx.x; LAS unsigned char* kbuf = lds; LAS unsigned char* vbuf = lds + KBYTES;
#pragma unroll
    for (int i = 0; i < 4; ++i) { const int c = tid + 512 * i; *(LAS u32x4*)(kbuf + (c >> 3) * KSB + (c & 7) * 16) = g.kr[i]; vt_store(vbuf + (c >> 5) * VSB, c & 31, g.vr[i]); }
    if (tid < 128) *(LAS u32x4*)(kbuf + (256 + (tid >> 3)) * KSB + (tid & 7) * 16) = g.mr;
    else if (tid < 256) { const int t = tid - 128; vt_store(vbuf + (t >> 1) * VSB, 32 + (t & 1), g.mr); }
    else if (tid < 384) { const int t = tid - 256; *(LAS u32x4*)(vbuf + (t >> 1) * VSB + 544 + (t & 1) * 16) = (u32x4){0u, 0u, 0u, 0u}; }
}
DI void swa_compute(const Params& p, LAS unsigned char* lds, int b, int kvh, int I) {
    constexpr int KSB = 144, VSB = 592, KBYTES = 288 * KSB;
    unsigned char* ws = p.ws;
    const int tid = threadIdx.x, wid = __builtin_amdgcn_readfirstlane(tid >> 6), lane = tid & 63, ql = lane & 31, hf = lane >> 5;
    const bf16_t* proj = (const bf16_t*)(ws + OFF_PROJ);
    LAS unsigned char* kbuf = lds; LAS unsigned char* vbuf = lds + KBYTES;
    const int head = kvh * 8 + wid;
    const float slope2 = fexp2(-0.5f * (float)(head + 1)) * LOG2E, sink2 = p.od_sinks[head] * LOG2E;
    const bf16_t* rowp = proj + ((size_t)b * SEQ + 128 * I + ql) * 2304;
    bf16x8 qf[4];
#pragma unroll
    for (int ks = 0; ks < 4; ++ks) qf[ks] = *(const bf16x8*)(rowp + head * 64 + 16 * ks + 8 * hf);
#pragma unroll 1
    for (int qs = 0; qs < 4; ++qs) {
        const int qrow = 32 * (4 * I + qs) + ql;
        const bf16_t* nrow = rowp + (size_t)(qs < 3 ? 32 * (qs + 1) : 32 * qs) * 2304;
        bf16x8 qn[4];
#pragma unroll
        for (int ks = 0; ks < 4; ++ks) qn[ks] = *(const bf16x8*)(nrow + head * 64 + 16 * ks + 8 * hf);
        const bf16_t* gptr = rowp + (size_t)(32 * qs) * 2304 + 1280 + head * 64;
        u32x4 gq4[4];
#pragma unroll
        for (int k = 0; k < 4; ++k) gq4[k] = *(const u32x4*)(gptr + 16 * k + 8 * hf);
        f32x16 O[2];
#pragma unroll
        for (int i = 0; i < 16; ++i) { O[0][i] = 0.f; O[1][i] = 0.f; }
        float mrun = sink2, lpart = (hf == 0) ? 1.f : 0.f;
#pragma unroll 1
        for (int pr_ = 0; pr_ < 3; ++pr_) {
            int subs[2]; subs[0] = (pr_ == 0) ? 8 : qs + 2 * pr_ - 1; subs[1] = qs + 2 * pr_;
            f32x16 s[2]; bool have[2]; int lo_[2], hi_[2]; float nb_[2];
#pragma unroll
            for (int t = 0; t < 2; ++t) {
                const int sub = subs[t]; int lo = -1000, hi = 1000; float nb;
                if (sub == 8) { have[t] = true; hi = 15 - 4 * hf; nb = -slope2 * (float)(16 + qrow - 4 * hf); }
                else { have[t] = !(I == 0 && sub < 4); const int k = qs + 4 - sub; const int Dl = 32 * k + ql; nb = -slope2 * (float)(Dl - 4 * hf);
                    if (k == 0) hi = Dl - 4 * hf; if (k == 4) lo = Dl - 127 - 4 * hf; }
                lo_[t] = lo; hi_[t] = hi; nb_[t] = nb;
            }
            bf16x8 kf0[4], kf1[4], vf0[2][2], vf1[2][2];
            if (have[0]) k_frags<4, 72>(kbuf, subs[0], ql, hf, kf0);
            __builtin_amdgcn_sched_barrier(0);
            if (have[0]) { f32x16 ini; const float c0 = nb_[0] - mrun;
#pragma unroll
                for (int i = 0; i < 16; ++i) ini[i] = slope2 * (float)(8 * (i >> 2) + (i & 3)) + c0;
                s[0] = qk_mma<4>(kf0, qf, ini); }
            if (have[1]) k_frags<4, 72>(kbuf, subs[1], ql, hf, kf1);
            __builtin_amdgcn_sched_barrier(0);
            if (have[1]) { f32x16 ini; const float c0 = nb_[1] - mrun;
#pragma unroll
                for (int i = 0; i < 16; ++i) ini[i] = slope2 * (float)(8 * (i >> 2) + (i & 3)) + c0;
                s[1] = qk_mma<4>(kf1, qf, ini); }
#pragma unroll
            for (int t = 0; t < 2; ++t) {
                if (have[t]) {
                    if (hi_[t] < 1000) {
#pragma unroll
                        for (int i = 0; i < 16; ++i) { const int cst = 8 * (i >> 2) + (i & 3); s[t][i] = (cst <= hi_[t]) ? s[t][i] : -1e30f; }
                    }
                    if (lo_[t] > -1000) {
#pragma unroll
                        for (int i = 0; i < 16; ++i) { const int cst = 8 * (i >> 2) + (i & 3); s[t][i] = (cst >= lo_[t]) ? s[t][i] : -1e30f; }
                    }
                }
            }
            softmax_update(s, have, false, hf, mrun, lpart, O);
            if (have[0]) { v_frags<VSB>(vbuf, subs[0], ql, hf, vf0); pv_mma(vf0, s[0], O); }
            if (have[1]) { v_frags<VSB>(vbuf, subs[1], ql, hf, vf1); pv_mma(vf1, s[1], O); }
        }
        const float inv = 1.f / (lpart + xor32(lpart, hf));
        bf16_t* optr = (bf16_t*)(ws + OFF_HN) + ((size_t)b * SEQ + qrow) * 1024 + head * 64;
        attn_store(O, inv, gq4, optr, hf);
#pragma unroll
        for (int ks = 0; ks < 4; ++ks) qf[ks] = qn[ks];
    }
}
DI void attn1_phase(const Params& p, LAS unsigned char* lds) {
    for (int it = blockIdx.x; it < 512; it += gridDim.x) {
        { SwaRegs g; swa_load(p, it >> 5, (it >> 4) & 1, it & 15, g);
          __syncthreads();
          swa_stash(lds, g); }
        __syncthreads();
        swa_compute(p, lds, it >> 5, (it >> 4) & 1, it & 15);
    }
}

#define XB_TMO      128
#define XB_XCNT(j)  (256  + 64 * (j))
#define XB_XSUB(j)  (1280 + 64 * (j))
#define XB_XGEN(j)  (2304 + 64 * (j))
#define XB_TOP      3328
#define XB_TOPGEN   3392
#define XCD_BAR_WORDS 3456
#define XB_SPIN_CAP (1u << 18)
DI unsigned xb_ld(unsigned* p)              { return __hip_atomic_load(p, __ATOMIC_RELAXED, __HIP_MEMORY_SCOPE_AGENT); }
DI unsigned xb_add(unsigned* p, unsigned v) { return __hip_atomic_fetch_add(p, v, __ATOMIC_RELAXED, __HIP_MEMORY_SCOPE_AGENT); }
DI unsigned xb_xcc_id() { return (unsigned)__builtin_amdgcn_s_getreg((3 << 11) | 20) & 0xFu; }
#define XB_SPIN(cond, bar) do { unsigned _sp = 0; while (cond) { __builtin_amdgcn_s_sleep(1); \
    if ((++_sp & 255u) == 0u) { if (xb_ld(&(bar)[XB_TMO])) break; if (_sp > XB_SPIN_CAP) { atomicAdd(&(bar)[XB_TMO], 1u); break; } } } } while (0)
struct XcdBarrier { unsigned* bar; unsigned x; volatile LAS unsigned* st; };
DI XcdBarrier xcd_barrier_post(unsigned* bar, volatile LAS unsigned* st) {
    XcdBarrier b; b.bar = bar; b.x = xb_xcc_id(); b.st = st;
    if (threadIdx.x == 0) (void)xb_add(&bar[XB_XCNT(b.x)], 1u);
    return b;
}
DI void xcd_barrier_complete(unsigned* bar, unsigned x, unsigned& nloc, unsigned& nx) {
    const unsigned G = gridDim.x * gridDim.y * gridDim.z;
    unsigned sum, cnt, mine, sp = 0u;
    for (;;) {
        sum = 0u; cnt = 0u; mine = 0u;
#pragma unroll
        for (unsigned j = 0; j < 16; ++j) { const unsigned c = xb_ld(&bar[XB_XCNT(j)]); sum += c; cnt += (c > 0u) ? 1u : 0u; mine = (j == x) ? c : mine; }
        if (sum == G) break;
        __builtin_amdgcn_s_sleep(1);
        if ((++sp & 255u) == 0u) { if (xb_ld(&bar[XB_TMO])) break; if (sp > XB_SPIN_CAP) { atomicAdd(&bar[XB_TMO], 1u); break; } }
    }
    nloc = mine > 0u ? mine : 1u; nx = cnt > 0u ? cnt : 1u;
}
DI void xcd_barrier(const XcdBarrier& b) {
    asm volatile("s_waitcnt vmcnt(0)" ::: "memory");
    __syncthreads();
    if (threadIdx.x == 0) {
        unsigned* bar = b.bar;
        __builtin_amdgcn_s_waitcnt(0);
        unsigned nloc = b.st[0], nx = b.st[1];
        if (nloc == 0u) { xcd_barrier_complete(bar, b.x, nloc, nx); b.st[0] = nloc; b.st[1] = nx; }
        const unsigned old = xb_add(&bar[XB_XSUB(b.x)], 1u);
        const unsigned gen = old / nloc;
        if (old + 1u == (gen + 1u) * nloc) {
            __builtin_amdgcn_fence(__ATOMIC_RELEASE, "agent");
            asm volatile("s_waitcnt vmcnt(0)" ::: "memory");
            const unsigned og = xb_add(&bar[XB_TOP], 1u);
            const unsigned tg = og / nx;
            if (og + 1u == (tg + 1u) * nx) xb_add(&bar[XB_TOPGEN], 1u);
            else XB_SPIN(xb_ld(&bar[XB_TOPGEN]) == tg, bar);
            __builtin_amdgcn_fence(__ATOMIC_ACQUIRE, "agent");
            xb_add(&bar[XB_XGEN(b.x)], 1u);
            asm volatile("s_waitcnt vmcnt(0)" ::: "memory");
        } else {
            XB_SPIN(xb_ld(&bar[XB_XGEN(b.x)]) == gen, bar);
            __builtin_amdgcn_fence(__ATOMIC_ACQUIRE, "agent");
            asm volatile("s_waitcnt vmcnt(0)" ::: "memory");
        }
    }
    __syncthreads();
}

template <int PH> DI void run_phase(const Params& p, LAS unsigned char* lds) {
    const int tid = threadIdx.x, wid = tid >> 6, lane = tid & 63;
    if (PH == 0) prep_phase(p, lds);
    else if (PH == 1) { gemm_phase<1>(p, lds); meta_phase<1>(p, lds); }
    else if (PH == 2) { gemm_phase<2>(p, lds); meta_phase<2>(p, lds);
        if (gridDim.x == 256) { if (blockIdx.x >= 128) weight_jobs(p, lds, WJ_EARLY, WJ_ALL, (blockIdx.x - 128) * 8 + wid, 128 * 8); }
        else weight_jobs(p, lds, WJ_EARLY, WJ_ALL, blockIdx.x * 8 + wid, gridDim.x * 8); }
    else if (PH == 3) { if (wid >= 4) __builtin_amdgcn_s_setprio(1); attn0_phase(p, lds); __builtin_amdgcn_s_setprio(0); }
    else if (PH == 4) { gemm_phase<4>(p, lds); meta_phase<4>(p, lds); }
    else if (PH == 5) {
        const int gw = blockIdx.x * 8 + wid, ngw = gridDim.x * 8;
        for (int row = gw; row < R; row += 2 * ngw) { const int r1 = row + ngw; const bool two = r1 < R;
            norm_rows_bf16(p.x, (const bf16_t*)(p.ws + OFF_D1), (size_t)row, (size_t)(two ? r1 : row), two, p.norm_g + 1024, (bf16_t*)(p.ws + OFF_HN), lane); }
        for (int row = gw; row < NMETA; row += ngw) norm_rows_bf16((const float*)(p.ws + OFF_H1_META), nullptr, (size_t)row, (size_t)row, false, p.norm_g + 1024, (bf16_t*)(p.ws + OFF_HN_META), lane);
    }
    else if (PH == 6) { gemm_phase<6>(p, lds); meta_phase<6>(p, lds); }
    else if (PH == 7) { if (wid >= 4) __builtin_amdgcn_s_setprio(1); attn1_phase(p, lds); __builtin_amdgcn_s_setprio(0); }
    else if (PH == 8) gemm_phase<8>(p, lds);
    else if (PH == 9) {
        const int gw = blockIdx.x * 8 + wid, ngw = gridDim.x * 8;
        for (int row = gw; row < R; row += 2 * ngw) { const int r1 = row + ngw; const bool two = r1 < R;
            norm_rows_f32(p.x, (const bf16_t*)(p.ws + OFF_D1), (const bf16_t*)(p.ws + OFF_D2), (size_t)row, (size_t)(two ? r1 : row), two, p.final_g, p.out, lane); }
    }
}

__global__ void __launch_bounds__(512, 2) mk_fwd(Params p) {
    extern __shared__ __attribute__((aligned(16))) unsigned char shm[];
    LAS unsigned char* lds = (LAS unsigned char*)shm;
    cg::grid_group grid = cg::this_grid();
    volatile LAS unsigned* st = (volatile LAS unsigned*)(lds + 131072);
    if (threadIdx.x == 0) { st[0] = 0u; st[1] = 0u; st[2] = 0u; st[3] = 0u; }
    __syncthreads();
    const XcdBarrier xb = xcd_barrier_post((unsigned*)(p.ws + OFF_BAR), st);
#define PHASE(n) do { if (p.ph_lo <= n && n < p.ph_hi) { run_phase<n>(p, lds); if (n + 1 < p.ph_hi) { if (p.ph_hi > 10) grid.sync(); else xcd_barrier(xb); } } } while (0)
    PHASE(0); PHASE(1); PHASE(2); PHASE(3); PHASE(4); PHASE(5); PHASE(6); PHASE(7); PHASE(8); PHASE(9);
}

extern "C" void kernel_launch(void* const* d_in, const int* in_sizes, int n_in, void* d_out, int out_size, void* d_ws, size_t ws_size, hipStream_t stream) {
    static int grid_blocks = 0;
    if (grid_blocks == 0) {
        if (n_in != 13 || ws_size < WS_END) { fprintf(stderr, "kernel_launch: unexpected inputs (n_in %d, ws %zu, need %zu)\n", n_in, ws_size, (size_t)WS_END); grid_blocks = -1; return; }
        int dev = 0, cus = 0, per_cu = 0;
        hipGetDevice(&dev);
        hipDeviceGetAttribute(&cus, hipDeviceAttributeMultiprocessorCount, dev);
        if (hipFuncSetAttribute((const void*)mk_fwd, hipFuncAttributeMaxDynamicSharedMemorySize, LDS_BYTES) != hipSuccess) { fprintf(stderr, "kernel_launch: hipFuncSetAttribute failed\n"); grid_blocks = -1; return; }
        if (hipOccupancyMaxActiveBlocksPerMultiprocessor(&per_cu, (const void*)mk_fwd, 512, LDS_BYTES) != hipSuccess || per_cu < 1) per_cu = 1;
        (void)hipGetLastError();
        grid_blocks = cus * per_cu;
    }
    if (grid_blocks < 0) return;
    Params p{};
    p.x = (const float*)d_in[0]; p.meta = (const float*)d_in[1]; p.norm_g = (const float*)d_in[2]; p.final_g = (const float*)d_in[3];
    p.ev_w_in = (const float*)d_in[4]; p.ev_qg = (const float*)d_in[5]; p.ev_kvg = (const float*)d_in[6]; p.ev_w_uq = (const float*)d_in[7];
    p.ev_w_ukv = (const float*)d_in[8]; p.ev_w_out = (const float*)d_in[9]; p.od_w_in = (const float*)d_in[10]; p.od_sinks = (const float*)d_in[11];
    p.od_w_out = (const float*)d_in[12];
    p.out = (float*)d_out; p.ws = (unsigned char*)d_ws;
    p.ph_lo = 0; p.ph_hi = 10;
    if (hipMemsetAsync((unsigned char*)d_ws + OFF_BAR, 0, BAR_BYTES, stream) != hipSuccess) { fprintf(stderr, "kernel_launch: memset of the barrier words failed\n"); return; }
    void* args[] = {&p};
    hipError_t e = hipLaunchCooperativeKernel((const void*)mk_fwd, dim3(grid_blocks), dim3(512), args, LDS_BYTES, stream);
    if (e != hipSuccess) fprintf(stderr, "cooperative launch failed: %s (grid %d)\n", hipGetErrorString(e), grid_blocks);
}
```

```cpp
#include <hip/hip_runtime.h>
#include <hip/hip_cooperative_groups.h>
#include <cstdio>
namespace cg = cooperative_groups;

#define DI __device__ __forceinline__
#define LAS __attribute__((address_space(3)))
typedef unsigned short bf16_t;
typedef short bf16x8 __attribute__((ext_vector_type(8)));
typedef short s16x4 __attribute__((ext_vector_type(4)));
typedef float f32x4 __attribute__((ext_vector_type(4)));
typedef float f32x16 __attribute__((ext_vector_type(16)));
typedef float f32x2_t __attribute__((ext_vector_type(2)));
typedef __bf16 bf16x2_t __attribute__((ext_vector_type(2)));
typedef unsigned u32x4 __attribute__((ext_vector_type(4)));
typedef unsigned u32x2 __attribute__((ext_vector_type(2)));

#ifndef COOP
#define COOP 1
#endif

constexpr int NBATCH = 16, SEQ = 2048, DM = 1024, R = NBATCH * SEQ, NMETA = 16;
constexpr float EPS = 1e-6f;
constexpr float LOG2E = 1.4426950408889634f;
constexpr int LDS_BYTES = 131072 + 256;
constexpr float QS64 = 0.125f * LOG2E, QS96 = 0.10206207261596575f * LOG2E;
constexpr float SB_THRESH = -152.f;

constexpr size_t OFF_WT_IN0 = 0;
constexpr size_t OFF_WT_UQ = OFF_WT_IN0 + (size_t)3072 * 1024 * 2;
constexpr size_t OFF_WT_UK = OFF_WT_UQ + (size_t)768 * 256 * 2;
constexpr size_t OFF_WT_UV = OFF_WT_UK + (size_t)512 * 256 * 2;
constexpr size_t OFF_WT_OUT0 = OFF_WT_UV + (size_t)512 * 256 * 2;
constexpr size_t OFF_WT_IN1 = OFF_WT_OUT0 + (size_t)1024 * 1024 * 2;
constexpr size_t OFF_WT_OUT1 = OFF_WT_IN1 + (size_t)2304 * 1024 * 2;
constexpr size_t OFF_HN = OFF_WT_OUT1 + (size_t)1024 * 1024 * 2;
constexpr size_t OFF_PROJ = OFF_HN + (size_t)R * 1024 * 2;
constexpr size_t OFF_VSBT = OFF_PROJ + (size_t)R * 3072 * 2;
constexpr size_t OFF_QM = OFF_VSBT + (size_t)512 * R * 2;
constexpr size_t OFF_KM = OFF_QM + (size_t)R * 768 * 2;
constexpr size_t OFF_VMT = OFF_KM + (size_t)R * 512 * 2;
constexpr size_t OFF_SSQ_Q = OFF_VMT + (size_t)512 * R * 2;
constexpr size_t OFF_SSQ_KV = OFF_SSQ_Q + (size_t)R * 4;
constexpr size_t OFF_COS = OFF_SSQ_KV + (size_t)R * 4;
constexpr size_t OFF_SIN = OFF_COS + (size_t)2064 * 16 * 4;
constexpr size_t OFF_HN_META = OFF_SIN + (size_t)2064 * 16 * 4;
constexpr size_t OFF_AO_META = OFF_HN_META + (size_t)16 * 1024 * 2;
constexpr size_t OFF_PROJ_META = OFF_AO_META + (size_t)16 * 1024 * 2;
constexpr size_t OFF_VSBT_META = OFF_PROJ_META + (size_t)16 * 3072 * 2;
constexpr size_t OFF_QM_META = OFF_VSBT_META + (size_t)512 * 16 * 2;
constexpr size_t OFF_KM_META = OFF_QM_META + (size_t)16 * 768 * 2;
constexpr size_t OFF_VMT_META = OFF_KM_META + (size_t)16 * 512 * 2;
constexpr size_t OFF_H1_META = OFF_VMT_META + (size_t)512 * 16 * 2;
constexpr size_t OFF_D1 = OFF_KM;
constexpr size_t OFF_D2 = OFF_PROJ;
constexpr size_t OFF_BAR = OFF_H1_META + (size_t)16 * 1024 * 4;
constexpr size_t BAR_BYTES = 16384;
constexpr size_t WS_END = OFF_BAR + BAR_BYTES;

struct Params {
    const float *x, *meta, *norm_g, *final_g, *ev_w_in, *ev_qg, *ev_kvg, *ev_w_uq, *ev_w_ukv, *ev_w_out, *od_w_in, *od_sinks, *od_w_out;
    float* out;
    unsigned char* ws;
    int ph_lo, ph_hi;
};

DI unsigned pk2(float a, float b) { f32x2_t v = {a, b}; return __builtin_bit_cast(unsigned, __builtin_convertvector(v, bf16x2_t)); }
DI float bflo(unsigned u) { return __uint_as_float(u << 16); }
DI float bfhi(unsigned u) { return __uint_as_float(u & 0xffff0000u); }
DI void st8(bf16_t* ptr, f32x4 a, f32x4 b) { u32x4 o; o.x = pk2(a[0], a[1]); o.y = pk2(a[2], a[3]); o.z = pk2(b[0], b[1]); o.w = pk2(b[2], b[3]); *(u32x4*)ptr = o; }
DI void st4(bf16_t* ptr, f32x4 v) { u32x2 o; o.x = pk2(v[0], v[1]); o.y = pk2(v[2], v[3]); *(u32x2*)ptr = o; }
DI float wave_sum(float s) {
#pragma unroll
    for (int o = 32; o >= 1; o >>= 1) s += __shfl_xor(s, o);
    return s;
}
DI float xor32(float x, int hf) {
    const unsigned xi = __float_as_uint(x); auto r = __builtin_amdgcn_permlane32_swap(xi, xi, false, false);
    return __uint_as_float(hf ? r[0] : r[1]);
}
DI float fexp2(float x) { return __builtin_amdgcn_exp2f(x); }
DI float flog2(float x) { return __builtin_amdgcn_logf(x); }

constexpr int BM = 256, BK = 64, HALF = 128, HTB = HALF * BK * 2, NXCD = 8, WGM = 8;
DI int lds_byte(int r, int c) { const int st = (r >> 4) * 2 + (c >> 5), rr = r & 15, cc = c & 31, ob = rr * 64 + cc * 2; return st * 1024 + (ob ^ (((ob >> 9) & 1) << 5)); }
DI void stage_rc(int b, int& Rr, int& Cc) { const int st = b / 1024, sb = b % 1024, swz = sb ^ (((sb >> 9) & 1) << 5); Rr = (st >> 1) * 16 + swz / 64; Cc = (st & 1) * 32 + (swz % 64) / 2; }

struct GUnit { const unsigned char* A; const unsigned char* B; int lda, ldb; int kind, row0, col0, perm; };
DI int perm32(int rho) { const int n = rho >> 4, i = rho & 15; return 8 * (i >> 2) + 4 * n + (i & 3); }

DI bool order_unit(int i, int nM, int nN, int& pm, int& pn) {
    const int nwg = nM * nN; const long L = (long)i * gridDim.x + blockIdx.x; if (L >= nwg) return false;
    int wgid = (int)L; { const int q = nwg / NXCD, r = nwg % NXCD, xcd = wgid % NXCD, off = wgid / NXCD; wgid = (xcd < r ? xcd * (q + 1) : r * (q + 1) + (xcd - r) * q) + off; }
    const int nig = WGM * nN, gid = wgid / nig, fm = gid * WGM, gsz = (nM - fm) < WGM ? (nM - fm) : WGM;
    pm = fm + ((wgid % nig) % gsz); pn = (wgid % nig) / gsz; return true;
}

template <int PH> struct PhCfg;
template <> struct PhCfg<1> { static constexpr int K = 1024, nM = 128, nN = 12; };
template <> struct PhCfg<2> { static constexpr int K = 256, nM = 128, nN = 7; };
template <> struct PhCfg<4> { static constexpr int K = 1024, nM = 128, nN = 4; };
template <> struct PhCfg<6> { static constexpr int K = 1024, nM = 128, nN = 10; };
template <> struct PhCfg<8> { static constexpr int K = 1024, nM = 128, nN = 4; };

template <int PH> DI bool get_unit(const Params& p, int i, GUnit& u) {
    int pm, pn; if (!order_unit(i, PhCfg<PH>::nM, PhCfg<PH>::nN, pm, pn)) return false;
    const unsigned char* ws = p.ws;
    if (PH == 1) {
        if (pn >= 6 && pn <= 9) pn = (pn < 8) ? pn + 2 : pn - 2;
        const unsigned char* a = ws + OFF_HN + (size_t)pm * 256 * 2048; const unsigned char* b = ws + OFF_WT_IN0 + (size_t)pn * 256 * 2048;
        u.lda = 2048; u.ldb = 2048;
        if (pn == 4 || pn == 5) { u.A = b; u.B = a; u.kind = 1; u.row0 = (pn - 4) * 256; u.col0 = pm * 256; }
        else { u.A = a; u.B = b; u.kind = 0; u.row0 = pm * 256; u.col0 = pn * 256; }
        u.perm = 1;
    } else if (PH == 2) {
        if (pn < 3) { u.A = ws + OFF_PROJ + ((size_t)pm * 256 * 3072 + 2048) * 2; u.lda = 6144; u.B = ws + OFF_WT_UQ + (size_t)pn * 256 * 512; u.ldb = 512; u.kind = 0; u.row0 = pm * 256; u.col0 = pn * 256; }
        else if (pn < 5) { u.A = ws + OFF_PROJ + ((size_t)pm * 256 * 3072 + 2304) * 2; u.lda = 6144; u.B = ws + OFF_WT_UK + (size_t)(pn - 3) * 256 * 512; u.ldb = 512; u.kind = 1; u.row0 = pm * 256; u.col0 = (pn - 3) * 256; }
        else { u.B = ws + OFF_PROJ + ((size_t)pm * 256 * 3072 + 2304) * 2; u.ldb = 6144; u.A = ws + OFF_WT_UV + (size_t)(pn - 5) * 256 * 512; u.lda = 512; u.kind = 2; u.row0 = (pn - 5) * 256; u.col0 = pm * 256; }
        u.perm = 1;
    } else if (PH == 4 || PH == 8) {
        u.A = ws + OFF_HN + (size_t)pm * 256 * 2048; u.B = ws + (PH == 4 ? OFF_WT_OUT0 : OFF_WT_OUT1) + (size_t)pn * 256 * 2048; u.lda = 2048; u.ldb = 2048; u.kind = 0; u.row0 = pm * 256; u.col0 = pn * 256; u.perm = 1;
    } else {
        const unsigned char* a = ws + OFF_HN + (size_t)pm * 256 * 2048;
        u.lda = 2048; u.ldb = 2048;
        if (pn == 9) { u.A = ws + OFF_WT_IN1 + (size_t)4 * 256 * 2048; u.B = a; u.kind = 1; u.row0 = 0; u.col0 = pm * 256; }
        else { u.A = a; u.B = ws + OFF_WT_IN1 + (size_t)pn * 256 * 2048; u.kind = 0; u.row0 = pm * 256; u.col0 = pn * 256; }
        u.perm = 1;
    }
    return true;
}

DI void rope_perm(f32x4& v0, f32x4& v1, const float* cs, const float* sn, int fq) {
    const int hi = fq >> 1, jb = 8 * (fq & 1);
    const f32x4 c0 = *(const f32x4*)(cs + jb), c1 = *(const f32x4*)(cs + jb + 4);
    f32x4 s0 = *(const f32x4*)(sn + jb), s1 = *(const f32x4*)(sn + jb + 4);
    if (!hi) { s0 = -s0; s1 = -s1; }
    f32x4 o0, o1;
#pragma unroll
    for (int e = 0; e < 4; ++e) { o0[e] = xor32(v0[e], hi); o1[e] = xor32(v1[e], hi); }
    v0 = v0 * c0 + o0 * s0; v1 = v1 * c1 + o1 * s1;
}
template <int PH> DI void gemm_epi(const Params& p, const f32x4 (&acc)[2][2][4][2], const GUnit& u, int wr, int wc, int fr, int fq) {
    unsigned char* ws = p.ws;
    const int rbase = u.row0 + 64 * wr + fr, cbase = u.col0 + 32 * wc + (u.perm ? 8 : 4) * fq;
#define ST_PAIR(rowptr, bj, v0, v1) do { if (u.perm) st8((rowptr) + cbase + 128 * (bj), v0, v1); else { st4((rowptr) + cbase + 128 * (bj), v0); st4((rowptr) + cbase + 128 * (bj) + 16, v1); } } while (0)
    if (PH == 1) {
        if (u.kind == 1) {
            bf16_t* vt = (bf16_t*)(ws + OFF_VSBT);
#pragma unroll
            for (int ai = 0; ai < 2; ++ai)
#pragma unroll
                for (int m = 0; m < 4; ++m) { const int row = rbase + 128 * ai + 16 * m;
#pragma unroll
                    for (int bj = 0; bj < 2; ++bj) ST_PAIR(vt + (size_t)row * R, bj, acc[ai][bj][m][0], acc[ai][bj][m][1]); }
            return;
        }
        bf16_t* proj = (bf16_t*)(ws + OFF_PROJ);
        const float* cosT = (const float*)(ws + OFF_COS); const float* sinT = (const float*)(ws + OFF_SIN);
        const float qscale = (u.col0 < 512) ? QS64 : 1.f;
        const bool do_rope = (u.col0 == 2304) && (wc == 0);
#pragma unroll
        for (int ai = 0; ai < 2; ++ai)
#pragma unroll
            for (int m = 0; m < 4; ++m) {
                const int row = rbase + 128 * ai + 16 * m;
                f32x4 v[2][2];
#pragma unroll
                for (int bj = 0; bj < 2; ++bj)
#pragma unroll
                    for (int n = 0; n < 2; ++n) v[bj][n] = acc[ai][bj][m][n] * qscale;
                if (u.col0 == 2048) {
                    float s = 0.f;
#pragma unroll
                    for (int bj = 0; bj < 2; ++bj)
#pragma unroll
                        for (int n = 0; n < 2; ++n)
#pragma unroll
                            for (int e = 0; e < 4; ++e) s += v[bj][n][e] * v[bj][n][e];
                    s += __shfl_xor(s, 16); s += __shfl_xor(s, 32);
                    if (fq == 0) atomicAdd((float*)(ws + OFF_SSQ_Q) + row, s);
                }
                if (u.col0 == 2304) {
                    float s = 0.f;
#pragma unroll
                    for (int n = 0; n < 2; ++n)
#pragma unroll
                        for (int e = 0; e < 4; ++e) s += v[0][n][e] * v[0][n][e];
                    s += __shfl_xor(s, 16); s += __shfl_xor(s, 32);
                    if (fq == 0) atomicAdd((float*)(ws + OFF_SSQ_KV) + row, s);
                    if (do_rope) {
                        const int pos = 16 + (row & (SEQ - 1));
                        rope_perm(v[1][0], v[1][1], cosT + pos * 16, sinT + pos * 16, fq);
                    }
                }
#pragma unroll
                for (int bj = 0; bj < 2; ++bj) ST_PAIR(proj + (size_t)row * 3072, bj, v[bj][0], v[bj][1]);
            }
    } else if (PH == 2) {
        if (u.kind == 2) {
            bf16_t* vt = (bf16_t*)(ws + OFF_VMT); const float* ssq = (const float*)(ws + OFF_SSQ_KV);
            f32x4 rs[2][2];
#pragma unroll
            for (int bj = 0; bj < 2; ++bj)
#pragma unroll
                for (int n = 0; n < 2; ++n) { const f32x4 q = *(const f32x4*)(ssq + cbase + 128 * bj + (u.perm ? 4 : 16) * n);
#pragma unroll
                    for (int e = 0; e < 4; ++e) rs[bj][n][e] = rsqrtf(q[e] * (1.f / 128.f) + EPS); }
#pragma unroll
            for (int ai = 0; ai < 2; ++ai)
#pragma unroll
                for (int m = 0; m < 4; ++m) { const int row = rbase + 128 * ai + 16 * m;
#pragma unroll
                    for (int bj = 0; bj < 2; ++bj) ST_PAIR(vt + (size_t)row * R, bj, acc[ai][bj][m][0] * rs[bj][0], acc[ai][bj][m][1] * rs[bj][1]); }
            return;
        }
        const float* cosT = (const float*)(ws + OFF_COS); const float* sinT = (const float*)(ws + OFF_SIN);
        float rsv[2][4];
        { const float* ssq = (const float*)(ws + (u.kind == 0 ? OFF_SSQ_Q : OFF_SSQ_KV)); const float dinv = (u.kind == 0) ? (1.f / 256.f) : (1.f / 128.f), mul = (u.kind == 0) ? QS96 : 1.f;
          float raw[2][4];
#pragma unroll
          for (int ai = 0; ai < 2; ++ai)
#pragma unroll
              for (int m = 0; m < 4; ++m) raw[ai][m] = ssq[rbase + 128 * ai + 16 * m];
#pragma unroll
          for (int ai = 0; ai < 2; ++ai)
#pragma unroll
              for (int m = 0; m < 4; ++m) rsv[ai][m] = rsqrtf(raw[ai][m] * dinv + EPS) * mul; }
        if (u.kind == 0) {
            bf16_t* qm = (bf16_t*)(ws + OFF_QM);
            const bool rope0 = (((u.col0 >> 5) + wc) % 3 == 2), rope1 = (((u.col0 >> 5) + 4 + wc) % 3 == 2);
#pragma unroll
            for (int ai = 0; ai < 2; ++ai)
#pragma unroll
                for (int m = 0; m < 4; ++m) {
                    const int row = rbase + 128 * ai + 16 * m; const float rs = rsv[ai][m]; const int pos = 16 + (row & (SEQ - 1));
#pragma unroll
                    for (int bj = 0; bj < 2; ++bj) {
                        f32x4 v0 = acc[ai][bj][m][0] * rs, v1 = acc[ai][bj][m][1] * rs;
                        if (bj == 0 ? rope0 : rope1) rope_perm(v0, v1, cosT + pos * 16, sinT + pos * 16, fq);
                        ST_PAIR(qm + (size_t)row * 768, bj, v0, v1);
                    }
                }
        } else {
            bf16_t* km = (bf16_t*)(ws + OFF_KM);
#pragma unroll
            for (int ai = 0; ai < 2; ++ai)
#pragma unroll
                for (int m = 0; m < 4; ++m) { const int row = rbase + 128 * ai + 16 * m; const float rs = rsv[ai][m];
#pragma unroll
                    for (int bj = 0; bj < 2; ++bj) ST_PAIR(km + (size_t)row * 512, bj, acc[ai][bj][m][0] * rs, acc[ai][bj][m][1] * rs); }
        }
    } else if (PH == 4 || PH == 8) {
        bf16_t* dst = (bf16_t*)(ws + (PH == 4 ? OFF_D1 : OFF_D2));
#pragma unroll
        for (int ai = 0; ai < 2; ++ai)
#pragma unroll
            for (int m = 0; m < 4; ++m) { const int row = rbase + 128 * ai + 16 * m;
#pragma unroll
                for (int bj = 0; bj < 2; ++bj) ST_PAIR(dst + (size_t)row * 1024, bj, acc[ai][bj][m][0], acc[ai][bj][m][1]); }
    } else {
        bf16_t* dst = (bf16_t*)(ws + (u.kind == 1 ? OFF_VSBT : OFF_PROJ)); const size_t ld = (u.kind == 1) ? (size_t)R : (size_t)2304;
        const float qscale = (u.kind == 0 && u.col0 < 1024) ? QS64 : 1.f;
#pragma unroll
        for (int ai = 0; ai < 2; ++ai)
#pragma unroll
            for (int m = 0; m < 4; ++m) { const int row = rbase + 128 * ai + 16 * m;
#pragma unroll
                for (int bj = 0; bj < 2; ++bj) ST_PAIR(dst + (size_t)row * ld, bj, acc[ai][bj][m][0] * qscale, acc[ai][bj][m][1] * qscale); }
    }
#undef ST_PAIR
}

template <int PH>
DI void gemm_phase(const Params& p, LAS unsigned char* lds) {
    constexpr int K = PhCfg<PH>::K, nt = K / BK;
    const int tid = threadIdx.x, wid = __builtin_amdgcn_readfirstlane(tid >> 6), lane = tid & 63, wr = wid >> 2, wc = wid & 3, fr = lane & 15, fq = lane >> 4;
    int Rr[2], Rp[2], Cc2[2];
#pragma unroll
    for (int i = 0; i < 2; ++i) { int a, b; stage_rc(tid * 16 + i * 8192, a, b); Rr[i] = a; Rp[i] = (a & ~31) + perm32(a & 31); Cc2[i] = b * 2; }
    const size_t kstep = (size_t)(BK * 2);
    const unsigned ldsw = (unsigned)wid * 1024u;
    const int aoff = lds_byte(wr * 64 + fr, fq * 8), boff = lds_byte(wc * 32 + fr, fq * 8);
#define G_SA(b, h) (((b) * 2 + (h)) * HTB)
#define G_SB(b, h) ((4 + (b) * 2 + (h)) * HTB)
#define G_STAGEB(bufoff, gbase, ld, pf) do { _Pragma("unroll") for (int _i = 0; _i < 2; ++_i) \
        __builtin_amdgcn_global_load_lds((const unsigned*)((gbase) + (size_t)(((pf) ? Rp[_i] : Rr[_i]) * (ld) + Cc2[_i])), (LAS unsigned*)(lds + (bufoff) + ldsw + _i * 8192), 16, 0, 0); } while (0)
#define G_STAGE(bufoff, gbase, ld) do { _Pragma("unroll") for (int _i = 0; _i < 2; ++_i) \
        __builtin_amdgcn_global_load_lds((const unsigned*)((gbase) + (size_t)(Rr[_i] * (ld) + Cc2[_i])), (LAS unsigned*)(lds + (bufoff) + ldsw + _i * 8192), 16, 0, 0); } while (0)
#define G_LDA(dst, b, h) do { _Pragma("unroll") for (int m = 0; m < 4; ++m) _Pragma("unroll") for (int k = 0; k < 2; ++k) dst[m][k] = *(const LAS bf16x8*)(lds + G_SA(b, h) + aoff + m * 2048 + k * 1024); } while (0)
#define G_LDB(dst, b, h) do { _Pragma("unroll") for (int n = 0; n < 2; ++n) _Pragma("unroll") for (int k = 0; k < 2; ++k) dst[n][k] = *(const LAS bf16x8*)(lds + G_SB(b, h) + boff + n * 2048 + k * 1024); } while (0)
#define G_MMA(ai, bj, At, Bt) do { __builtin_amdgcn_s_setprio(1); _Pragma("unroll") for (int m = 0; m < 4; ++m) _Pragma("unroll") for (int n = 0; n < 2; ++n) _Pragma("unroll") for (int k = 0; k < 2; ++k) \
        acc[ai][bj][m][n] = __builtin_amdgcn_mfma_f32_16x16x32_bf16(Bt[n][k], At[m][k], acc[ai][bj][m][n], 0, 0, 0); __builtin_amdgcn_s_setprio(0); } while (0)
#define G_WAIT_V(n) asm volatile("s_waitcnt vmcnt(" #n ")" ::: "memory")
#define G_WAIT_L(n) asm volatile("s_waitcnt lgkmcnt(" #n ")" ::: "memory")
#define G_BAR __builtin_amdgcn_s_barrier()
#define G_SCHED __builtin_amdgcn_sched_barrier(0)
    GUnit cur, nxt; int ui = 0;
    if (!get_unit<PH>(p, 0, cur)) return;
    f32x4 acc[2][2][4][2];
#pragma unroll
    for (int a = 0; a < 2; ++a)
#pragma unroll
        for (int b = 0; b < 2; ++b)
#pragma unroll
            for (int m = 0; m < 4; ++m)
#pragma unroll
                for (int n = 0; n < 2; ++n) acc[a][b][m][n] = (f32x4){0.f, 0.f, 0.f, 0.f};
    bf16x8 At[4][2], B0[2][2], B1[2][2];
    const unsigned char* cA = cur.A; const unsigned char* cB = cur.B; int lda = cur.lda, ldb = cur.ldb; int pfc = cur.perm;
    {
        const size_t hA = (size_t)HALF * lda, hB = (size_t)HALF * ldb;
        G_STAGEB(G_SB(0, 0), cB, ldb, pfc); G_STAGE(G_SA(0, 0), cA, lda); G_STAGEB(G_SB(0, 1), cB + hB, ldb, pfc); G_STAGE(G_SA(0, 1), cA + hA, lda);
        if (wr == 1) G_BAR;
        G_WAIT_V(4); G_BAR;
        G_STAGEB(G_SB(1, 0), cB + kstep, ldb, pfc); G_STAGE(G_SA(1, 0), cA + kstep, lda); G_STAGEB(G_SB(1, 1), cB + hB + kstep, ldb, pfc);
        G_WAIT_V(6); G_BAR;
    }
    for (;;) {
        const bool has_next = get_unit<PH>(p, ui + 1, nxt);
        const unsigned char* nA = has_next ? nxt.A : cA; const unsigned char* nB = has_next ? nxt.B : cB;
        const int nlda = has_next ? nxt.lda : lda, nldb = has_next ? nxt.ldb : ldb, npf = has_next ? nxt.perm : pfc;
        _Pragma("unroll 1") for (int t = 0; t < nt; t += 2) {
            const bool last = (t == nt - 2);
            const unsigned char* a1 = cA + (size_t)(t + 1) * kstep;
            const unsigned char* a2 = last ? nA : cA + (size_t)(t + 2) * kstep; const unsigned char* b2 = last ? nB : cB + (size_t)(t + 2) * kstep;
            const int lda2 = last ? nlda : lda, ldb2 = last ? nldb : ldb, pf2 = last ? npf : pfc;
            const size_t hA1 = (size_t)HALF * lda, hA2 = (size_t)HALF * lda2, hB2 = (size_t)HALF * ldb2;
            const unsigned char* a3 = a2 + kstep; const unsigned char* b3 = b2 + kstep;
            G_LDB(B0, 0, 0); G_SCHED; G_LDA(At, 0, 0); G_STAGE(G_SA(1, 1), a1 + hA1, lda);
            G_WAIT_L(8); G_BAR; G_WAIT_L(0); G_MMA(0, 0, At, B0); G_BAR; G_SCHED;
            G_LDB(B1, 0, 1); G_STAGEB(G_SB(0, 0), b2, ldb2, pf2);
            G_BAR; G_WAIT_L(0); G_MMA(0, 1, At, B1); G_BAR;
            G_LDA(At, 0, 1); G_STAGE(G_SA(0, 0), a2, lda2);
            G_BAR; G_WAIT_L(0); G_MMA(1, 0, At, B0); G_BAR; G_SCHED;
            G_STAGEB(G_SB(0, 1), b2 + hB2, ldb2, pf2);
            G_WAIT_V(6); G_BAR; G_MMA(1, 1, At, B1); G_BAR;
            G_LDB(B0, 1, 0); G_SCHED; G_LDA(At, 1, 0); G_STAGE(G_SA(0, 1), a2 + hA2, lda2);
            G_WAIT_L(8); G_BAR; G_WAIT_L(0); G_MMA(0, 0, At, B0); G_BAR; G_SCHED;
            G_LDB(B1, 1, 1); G_STAGEB(G_SB(1, 0), b3, ldb2, pf2);
            G_BAR; G_WAIT_L(0); G_MMA(0, 1, At, B1); G_BAR;
            G_LDA(At, 1, 1); G_STAGE(G_SA(1, 0), a3, lda2);
            G_BAR; G_WAIT_L(0); G_MMA(1, 0, At, B0); G_BAR; G_SCHED;
            G_STAGEB(G_SB(1, 1), b3 + hB2, ldb2, pf2);
            G_WAIT_V(6); G_BAR; G_MMA(1, 1, At, B1); G_BAR;
        }
        gemm_epi<PH>(p, acc, cur, wr, wc, fr, fq);
        if (!has_next) break;
#pragma unroll
        for (int a = 0; a < 2; ++a)
#pragma unroll
            for (int b = 0; b < 2; ++b)
#pragma unroll
                for (int m = 0; m < 4; ++m)
#pragma unroll
                    for (int n = 0; n < 2; ++n) acc[a][b][m][n] = (f32x4){0.f, 0.f, 0.f, 0.f};
        cur = nxt; cA = nA; cB = nB; lda = nlda; ldb = nldb; pfc = npf; ++ui;
    }
    G_WAIT_V(0);
    if (wr == 0) G_BAR;
    G_BAR;
#undef G_SA
#undef G_SB
#undef G_STAGE
#undef G_STAGEB
#undef G_LDA
#undef G_LDB
#undef G_MMA
#undef G_WAIT_V
#undef G_WAIT_L
#undef G_BAR
#undef G_SCHED
}

DI void tiny_gemm(const bf16_t* A, int lda, const bf16_t* Bt, int ldb, int K, int cgp, int lane, int wid, LAS unsigned char* lds, f32x4& c0, f32x4& c1) {
    const int fr = lane & 15, fq = lane >> 4, kper = K >> 3;
    c0 = (f32x4){0.f, 0.f, 0.f, 0.f}; c1 = c0;
    const bf16_t* ap = A + (size_t)fr * lda + fq * 8 + wid * kper; const bf16_t* b0 = Bt + (size_t)(32 * cgp + fr) * ldb + fq * 8 + wid * kper; const bf16_t* b1 = b0 + (size_t)16 * ldb;
#pragma unroll 4
    for (int k = 0; k < kper; k += 32) {
        const bf16x8 a = *(const bf16x8*)(ap + k), x = *(const bf16x8*)(b0 + k), y = *(const bf16x8*)(b1 + k);
        c0 = __builtin_amdgcn_mfma_f32_16x16x32_bf16(a, x, c0, 0, 0, 0);
        c1 = __builtin_amdgcn_mfma_f32_16x16x32_bf16(a, y, c1, 0, 0, 0);
    }
    LAS f32x4* red = (LAS f32x4*)lds;
    red[(wid * 2 + 0) * 64 + lane] = c0; red[(wid * 2 + 1) * 64 + lane] = c1;
    __syncthreads();
    if (wid == 0) {
#pragma unroll
        for (int w = 1; w < 8; ++w) { c0 += red[(w * 2 + 0) * 64 + lane]; c1 += red[(w * 2 + 1) * 64 + lane]; }
    }
    __syncthreads();
}
DI float meta_rs(const bf16_t* src, int ld, int ncol, int lane) {
    const int row = lane & 15, part = lane >> 4, per = ncol / 4; float s = 0.f;
    const bf16_t* q = src + (size_t)row * ld + part * per;
    for (int k = 0; k < per; ++k) { const float v = __uint_as_float(((unsigned)q[k]) << 16); s += v * v; }
    s += __shfl_xor(s, 16); s += __shfl_xor(s, 32);
    return rsqrtf(s / (float)ncol + EPS);
}
DI unsigned short bf1(float x) { return (unsigned short)(pk2(x, 0.f) & 0xffffu); }

template <int PH> DI void meta_phase(const Params& p, LAS unsigned char* lds) {
    unsigned char* ws = p.ws;
    const int tid = threadIdx.x, wid = tid >> 6, lane = tid & 63, fr = lane & 15, fq = lane >> 4;
    const float* cosT = (const float*)(ws + OFF_COS); const float* sinT = (const float*)(ws + OFF_SIN);
    f32x4 c0, c1;
    if (PH == 1) {
        bf16_t* pm = (bf16_t*)(ws + OFF_PROJ_META); bf16_t* vt = (bf16_t*)(ws + OFF_VSBT_META);
        for (int u = blockIdx.x; u < 96; u += gridDim.x) {
            tiny_gemm((const bf16_t*)(ws + OFF_HN_META), 1024, (const bf16_t*)(ws + OFF_WT_IN0), 1024, 1024, u, lane, wid, lds, c0, c1);
            if (wid == 0) {
                if (u < 16) { c0 = c0 * QS64; c1 = c1 * QS64; }
                if (u == 76) {
#pragma unroll
                    for (int e = 0; e < 4; ++e) { const int m = 4 * fq + e; const float c = cosT[m * 16 + fr], s = sinT[m * 16 + fr]; const float x1 = c0[e], x2 = c1[e]; c0[e] = x1 * c - x2 * s; c1[e] = x1 * s + x2 * c; }
                }
#pragma unroll
                for (int e = 0; e < 4; ++e) { const int m = 4 * fq + e; const int col = 32 * u + fr;
                    const unsigned short h0 = bf1(c0[e]), h1 = bf1(c1[e]);
                    pm[m * 3072 + col] = h0; pm[m * 3072 + col + 16] = h1;
                    if (col >= 1024 && col < 1536) { vt[(col - 1024) * 16 + m] = h0; vt[(col - 1024 + 16) * 16 + m] = h1; } }
            }
        }
    } else if (PH == 2) {
        const bf16_t* pm = (const bf16_t*)(ws + OFF_PROJ_META);
        for (int u = blockIdx.x; u < 56; u += gridDim.x) {
            if (u < 24) {
                tiny_gemm(pm + 2048, 3072, (const bf16_t*)(ws + OFF_WT_UQ), 256, 256, u, lane, wid, lds, c0, c1);
                if (wid == 0) {
                    const float rsv = meta_rs(pm + 2048, 3072, 256, lane);
                    bf16_t* qm = (bf16_t*)(ws + OFF_QM_META);
#pragma unroll
                    for (int e = 0; e < 4; ++e) { const int m = 4 * fq + e; const float rs = __shfl(rsv, m) * QS96; float x1 = c0[e] * rs, x2 = c1[e] * rs;
                        if (u % 3 == 2) { const float c = cosT[m * 16 + fr], s = sinT[m * 16 + fr]; const float y1 = x1 * c - x2 * s, y2 = x1 * s + x2 * c; x1 = y1; x2 = y2; }
                        qm[m * 768 + 32 * u + fr] = bf1(x1); qm[m * 768 + 32 * u + 16 + fr] = bf1(x2); }
                }
            } else {
                const int isv = (u >= 40), uu = isv ? u - 40 : u - 24;
                tiny_gemm(pm + 2304, 3072, (const bf16_t*)(ws + (isv ? OFF_WT_UV : OFF_WT_UK)), 256, 256, uu, lane, wid, lds, c0, c1);
                if (wid == 0) {
                    const float rsv = meta_rs(pm + 2304, 3072, 128, lane);
#pragma unroll
                    for (int e = 0; e < 4; ++e) { const int m = 4 * fq + e; const float rs = __shfl(rsv, m); const int col = 32 * uu + fr;
                        const unsigned short h0 = bf1(c0[e] * rs), h1 = bf1(c1[e] * rs);
                        if (isv) { bf16_t* vt = (bf16_t*)(ws + OFF_VMT_META); vt[col * 16 + m] = h0; vt[(col + 16) * 16 + m] = h1; }
                        else { bf16_t* km = (bf16_t*)(ws + OFF_KM_META); km[m * 512 + col] = h0; km[m * 512 + col + 16] = h1; } }
                }
            }
        }
    } else if (PH == 4) {
        float* h1 = (float*)(ws + OFF_H1_META);
        for (int u = blockIdx.x; u < 32; u += gridDim.x) {
            tiny_gemm((const bf16_t*)(ws + OFF_AO_META), 1024, (const bf16_t*)(ws + OFF_WT_OUT0), 1024, 1024, u, lane, wid, lds, c0, c1);
            if (wid == 0) {
#pragma unroll
                for (int e = 0; e < 4; ++e) { const int m = 4 * fq + e; const int col = 32 * u + fr;
                    h1[m * 1024 + col] = p.meta[m * 1024 + col] + c0[e]; h1[m * 1024 + col + 16] = p.meta[m * 1024 + col + 16] + c1[e]; }
            }
        }
    } else if (PH == 6) {
        bf16_t* pm = (bf16_t*)(ws + OFF_PROJ_META); bf16_t* vt = (bf16_t*)(ws + OFF_VSBT_META);
        for (int u = blockIdx.x; u < 8; u += gridDim.x) {
            const int cgp = 32 + u;
            tiny_gemm((const bf16_t*)(ws + OFF_HN_META), 1024, (const bf16_t*)(ws + OFF_WT_IN1), 1024, 1024, cgp, lane, wid, lds, c0, c1);
            if (wid == 0) {
#pragma unroll
                for (int e = 0; e < 4; ++e) { const int m = 4 * fq + e; const int col = 32 * cgp + fr;
                    const unsigned short h0 = bf1(c0[e]), h1v = bf1(c1[e]);
                    pm[m * 2304 + col] = h0; pm[m * 2304 + col + 16] = h1v;
                    vt[(col - 1024) * 16 + m] = h0; vt[(col - 1024 + 16) * 16 + m] = h1v; }
            }
        }
    }
}

DI void transpose_item(const float* W, int ldw, int Kv, int Nv, int k0, int n0, const float* gain, bf16_t* dst, int ldd, int drow0, int dcol0, LAS float* scr, int lane) {
    const int n = n0 + (lane & 31);
#pragma unroll 8
    for (int i = 0; i < 32; ++i) { const int kk = 2 * i + (lane >> 5), k = k0 + kk;
        float v = 0.f; if (k < Kv && n < Nv) { v = W[(size_t)k * ldw + n]; if (gain) v *= gain[k]; }
        scr[kk * 33 + (lane & 31)] = v; }
    asm volatile("s_waitcnt lgkmcnt(0)" ::: "memory");
    const int c = lane & 7;
#pragma unroll
    for (int j = 0; j < 4; ++j) { const int nn = (lane >> 3) + 8 * j; const LAS float* q = scr + (8 * c) * 33 + nn;
        u32x4 o; o.x = pk2(q[0 * 33], q[1 * 33]); o.y = pk2(q[2 * 33], q[3 * 33]); o.z = pk2(q[4 * 33], q[5 * 33]); o.w = pk2(q[6 * 33], q[7 * 33]);
        *(u32x4*)(dst + (size_t)(drow0 + nn) * ldd + dcol0 + 8 * c) = o; }
    asm volatile("s_waitcnt lgkmcnt(0)" ::: "memory");
}
DI void load_row(const float* x, const bf16_t* da, const bf16_t* db, int lane, f32x4 (&v)[4]) {
#pragma unroll
    for (int j = 0; j < 4; ++j) v[j] = ((const f32x4*)x)[lane + 64 * j];
    if (da) {
#pragma unroll
        for (int j = 0; j < 4; ++j) { const u32x2 q = ((const u32x2*)da)[lane + 64 * j]; v[j][0] += bflo(q.x); v[j][1] += bfhi(q.x); v[j][2] += bflo(q.y); v[j][3] += bfhi(q.y); }
    }
    if (db) {
#pragma unroll
        for (int j = 0; j < 4; ++j) { const u32x2 q = ((const u32x2*)db)[lane + 64 * j]; v[j][0] += bflo(q.x); v[j][1] += bfhi(q.x); v[j][2] += bflo(q.y); v[j][3] += bfhi(q.y); }
    }
}
DI float row_ssq(const f32x4 (&v)[4]) { float s = 0.f;
#pragma unroll
    for (int j = 0; j < 4; ++j) s += v[j][0] * v[j][0] + v[j][1] * v[j][1] + v[j][2] * v[j][2] + v[j][3] * v[j][3];
    return s; }
DI void norm_rows_bf16(const float* x, const bf16_t* da, size_t r0, size_t r1, bool two, const float* g, bf16_t* dst, int lane) {
    f32x4 v[4], w[4];
    load_row(x + r0 * 1024, da ? da + r0 * 1024 : nullptr, nullptr, lane, v);
    if (two) load_row(x + r1 * 1024, da ? da + r1 * 1024 : nullptr, nullptr, lane, w);
    else {
#pragma unroll
        for (int j = 0; j < 4; ++j) w[j] = (f32x4){0.f, 0.f, 0.f, 0.f};
    }
    const float rs = rsqrtf(wave_sum(row_ssq(v)) * (1.f / 1024.f) + EPS), rt = rsqrtf(wave_sum(row_ssq(w)) * (1.f / 1024.f) + EPS);
#pragma unroll
    for (int j = 0; j < 4; ++j) { const f32x4 gg = ((const f32x4*)g)[lane + 64 * j]; st4(dst + r0 * 1024 + 4 * (lane + 64 * j), v[j] * rs * gg); if (two) st4(dst + r1 * 1024 + 4 * (lane + 64 * j), w[j] * rt * gg); }
}
DI void norm_rows_f32(const float* x, const bf16_t* da, const bf16_t* db, size_t r0, size_t r1, bool two, const float* g, float* out, int lane) {
    f32x4 v[4], w[4];
    load_row(x + r0 * 1024, da + r0 * 1024, db + r0 * 1024, lane, v);
    if (two) load_row(x + r1 * 1024, da + r1 * 1024, db + r1 * 1024, lane, w);
    else {
#pragma unroll
        for (int j = 0; j < 4; ++j) w[j] = (f32x4){0.f, 0.f, 0.f, 0.f};
    }
    const float rs = rsqrtf(wave_sum(row_ssq(v)) * (1.f / 1024.f) + EPS), rt = rsqrtf(wave_sum(row_ssq(w)) * (1.f / 1024.f) + EPS);
#pragma unroll
    for (int j = 0; j < 4; ++j) { const f32x4 gg = ((const f32x4*)g)[lane + 64 * j]; ((f32x4*)(out + r0 * 1024))[lane + 64 * j] = v[j] * rs * gg; if (two) ((f32x4*)(out + r1 * 1024))[lane + 64 * j] = w[j] * rt * gg; }
}

constexpr int WJ_EARLY = 16 * 96 + 4 * 24 + 4 * 32, WJ_ALL = WJ_EARLY + 16 * 32 + 16 * 72 + 16 * 32;
DI void weight_jobs(const Params& p, LAS unsigned char* lds, int lo, int hi, int w0, int wstride) {
    unsigned char* ws = p.ws; const int wid = threadIdx.x >> 6, lane = threadIdx.x & 63;
    constexpr int J1 = 16 * 96, J2 = 4 * 24, J3 = 4 * 32, J4 = 16 * 32, J5 = 16 * 72;
    LAS float* scr = (LAS float*)(lds + wid * 8448);
    for (int job = lo + w0; job < hi; job += wstride) {
        int r = job;
        if (r < J1) { const int nt_ = r / 16, kt = r % 16; transpose_item(p.ev_w_in, 2976, 1024, 2976, kt * 64, nt_ * 32, nullptr, (bf16_t*)(ws + OFF_WT_IN0), 1024, nt_ * 32, kt * 64, scr, lane); continue; } r -= J1;
        if (r < J2) { const int nt_ = r / 4, kt = r % 4; transpose_item(p.ev_w_uq, 768, 256, 768, kt * 64, nt_ * 32, p.ev_qg, (bf16_t*)(ws + OFF_WT_UQ), 256, nt_ * 32, kt * 64, scr, lane); continue; } r -= J2;
        if (r < J3) { const int nts = r / 4, kt = r % 4;
            transpose_item(p.ev_w_ukv, 1024, 128, 1024, kt * 64, nts * 32, p.ev_kvg, (bf16_t*)(ws + (((nts >> 1) & 1) ? OFF_WT_UV : OFF_WT_UK)), 256, (nts >> 2) * 64 + (nts & 1) * 32, kt * 64, scr, lane); continue; } r -= J3;
        if (r < J4) { const int nt_ = r / 16, kt = r % 16; transpose_item(p.ev_w_out, 1024, 1024, 1024, kt * 64, nt_ * 32, nullptr, (bf16_t*)(ws + OFF_WT_OUT0), 1024, nt_ * 32, kt * 64, scr, lane); continue; } r -= J4;
        if (r < J5) { const int nt_ = r / 16, kt = r % 16; transpose_item(p.od_w_in, 2304, 1024, 2304, kt * 64, nt_ * 32, nullptr, (bf16_t*)(ws + OFF_WT_IN1), 1024, nt_ * 32, kt * 64, scr, lane); continue; } r -= J5;
        { const int nt_ = r / 16, kt = r % 16; transpose_item(p.od_w_out, 1024, 1024, 1024, kt * 64, nt_ * 32, nullptr, (bf16_t*)(ws + OFF_WT_OUT1), 1024, nt_ * 32, kt * 64, scr, lane); }
    }
}
DI void prep_phase(const Params& p, LAS unsigned char* lds) {
    unsigned char* ws = p.ws;
    const int tid = threadIdx.x, wid = tid >> 6, lane = tid & 63;
    weight_jobs(p, lds, 0, WJ_EARLY, blockIdx.x * 8 + wid, gridDim.x * 8);
    const int gtid = blockIdx.x * 512 + tid, ngt = gridDim.x * 512;
    for (int i = gtid; i < R; i += ngt) { ((float*)(ws + OFF_SSQ_Q))[i] = 0.f; ((float*)(ws + OFF_SSQ_KV))[i] = 0.f; }
    for (int i = gtid; i < 2064 * 16; i += ngt) {
        const int pos = i >> 4, j = i & 15;
        double inv = 1.0; { const int jq = j >> 2, jr = j & 3; for (int q = 0; q < jq; ++q) inv *= 0.1; inv *= (jr == 0 ? 1.0 : jr == 1 ? 0.5623413251903491 : jr == 2 ? 0.31622776601683794 : 0.1778279410038923); }
        double ang = (double)pos * inv; const double TWO_PI = 6.283185307179586476925;
        ang -= TWO_PI * __builtin_rint(ang * (1.0 / TWO_PI));
        const double x2 = ang * ang; double sn = 0.0, cs = 0.0, ts = ang, tc = 1.0;
        for (int k = 0; k < 16; ++k) { sn += ts; cs += tc; tc *= -x2 / (double)((2 * k + 1) * (2 * k + 2)); ts *= -x2 / (double)((2 * k + 2) * (2 * k + 3)); }
        ((float*)(ws + OFF_COS))[i] = (float)cs; ((float*)(ws + OFF_SIN))[i] = (float)sn;
    }
    const int gw = blockIdx.x * 8 + wid, ngw = gridDim.x * 8;
    for (int row = gw; row < R; row += 2 * ngw) { const int r1 = row + ngw; const bool two = r1 < R;
        norm_rows_bf16(p.x, nullptr, (size_t)row, (size_t)(two ? r1 : row), two, p.norm_g, (bf16_t*)(ws + OFF_HN), lane); }
    for (int row = gw; row < NMETA; row += ngw) norm_rows_bf16(p.meta, nullptr, (size_t)row, (size_t)row, false, p.norm_g, (bf16_t*)(ws + OFF_HN_META), lane);
}

DI f32x16 mfma32(bf16x8 a, bf16x8 b, f32x16 c) { return __builtin_amdgcn_mfma_f32_32x32x16_bf16(a, b, c, 0, 0, 0); }
constexpr int VSTR = 72;

template <int NKS, int KSTR>
DI void k_frags(LAS const unsigned char* kt, int sub, int ql, int hf, bf16x8 (&kf)[NKS]) {
    LAS const unsigned char* kp = kt + (32 * sub + ql) * (KSTR * 2) + hf * 16;
#pragma unroll
    for (int ks = 0; ks < NKS; ++ks) kf[ks] = *(LAS const bf16x8*)(kp + ks * 32);
}
template <int NKS>
DI f32x16 qk_mma(const bf16x8 (&kf)[NKS], const bf16x8 (&qf)[NKS], f32x16 s) {
#pragma unroll
    for (int ks = 0; ks < NKS; ++ks) s = mfma32(kf[ks], qf[ks], s);
    return s;
}
template <int VSB>
DI void v_frags(LAS const unsigned char* vt, int sub, int ql, int hf, bf16x8 (&vf)[2][2]) {
#pragma unroll
    for (int s2 = 0; s2 < 2; ++s2)
#pragma unroll
        for (int dt = 0; dt < 2; ++dt) vf[s2][dt] = *(LAS const bf16x8*)(vt + (32 * dt + ql) * VSB + (2 * sub + s2) * 32 + hf * 16);
}
DI void pv_mma(const bf16x8 (&vf)[2][2], const f32x16& pr, f32x16 (&O)[2]) {
#pragma unroll
    for (int s2 = 0; s2 < 2; ++s2) {
        u32x4 pp; pp.x = pk2(pr[8 * s2 + 0], pr[8 * s2 + 1]); pp.y = pk2(pr[8 * s2 + 2], pr[8 * s2 + 3]); pp.z = pk2(pr[8 * s2 + 4], pr[8 * s2 + 5]); pp.w = pk2(pr[8 * s2 + 6], pr[8 * s2 + 7]);
        const bf16x8 pf = __builtin_bit_cast(bf16x8, pp);
#pragma unroll
        for (int dt = 0; dt < 2; ++dt) O[dt] = mfma32(vf[s2][dt], pf, O[dt]);
    }
}
DI void vt_store(LAS unsigned char* rowp, int c, u32x4 v) {
    LAS unsigned char* q = rowp + 32 * (c >> 1) + 8 * (c & 1);
    u32x2 lo; lo.x = v.x; lo.y = v.y; u32x2 hi; hi.x = v.z; hi.y = v.w;
    *(LAS u32x2*)q = lo; *(LAS u32x2*)(q + 16) = hi;
}
DI f32x16 splat16(float v) { f32x16 s;
#pragma unroll
    for (int i = 0; i < 16; ++i) s[i] = v;
    return s; }
constexpr float SM_TAU = 8.f;
DI void softmax_update(f32x16 (&s)[2], const bool (&have)[2], bool first, int hf, float& mrun, float& lpart, f32x16 (&O)[2]) {
    int im = (int)0x80000000;
#pragma unroll
    for (int t = 0; t < 2; ++t) if (have[t]) {
#pragma unroll
        for (int i = 0; i < 16; i += 2) { const int a = (int)__float_as_uint(s[t][i]), b = (int)__float_as_uint(s[t][i + 1]); const int m2 = a > b ? a : b; im = im > m2 ? im : m2; }
    }
    if (first || __any(__uint_as_float((unsigned)im) > SM_TAU)) {
        float mx = -1e30f;
#pragma unroll
        for (int t = 0; t < 2; ++t) if (have[t]) {
#pragma unroll
            for (int i = 0; i < 16; ++i) mx = __builtin_fmaxf(mx, s[t][i]);
        }
        mx = __builtin_fmaxf(mx, xor32(mx, hf));
        const float d = first ? mx : __builtin_fmaxf(mx, 0.f);
        const float alpha = fexp2(-d);
        mrun += d; lpart *= alpha;
#pragma unroll
        for (int i = 0; i < 16; ++i) { O[0][i] *= alpha; O[1][i] *= alpha; }
#pragma unroll
        for (int t = 0; t < 2; ++t) if (have[t]) {
#pragma unroll
            for (int i = 0; i < 16; ++i) s[t][i] -= d;
        }
    }
    f32x2_t ps = {0.f, 0.f};
#pragma unroll
    for (int t = 0; t < 2; ++t) if (have[t]) {
#pragma unroll
        for (int i = 0; i < 16; i += 2) { f32x2_t e; e[0] = fexp2(s[t][i]); e[1] = fexp2(s[t][i + 1]); s[t][i] = e[0]; s[t][i + 1] = e[1]; ps += e; }
    }
    lpart += ps[0] + ps[1];
}
DI void attn_store(const f32x16 (&O)[2], float inv, const u32x4 (&gq)[4], bf16_t* orow, int hf) {
#pragma unroll
    for (int dt = 0; dt < 2; ++dt)
#pragma unroll
        for (int ap = 0; ap < 2; ++ap) {
            float A[4], B[4];
#pragma unroll
            for (int e = 0; e < 4; ++e) {
                const unsigned a = __float_as_uint(O[dt][8 * ap + e] * inv), b = __float_as_uint(O[dt][8 * ap + 4 + e] * inv);
                auto r = __builtin_amdgcn_permlane32_swap(a, b, false, false);
                A[e] = __uint_as_float(r[0]); B[e] = __uint_as_float(r[1]);
            }
            const u32x4 g = gq[2 * dt + ap];
            const float g0 = bflo(g.x), g1 = bfhi(g.x), g2 = bflo(g.y), g3 = bfhi(g.y), g4 = bflo(g.z), g5 = bfhi(g.z), g6 = bflo(g.w), g7 = bfhi(g.w);
            f32x4 lo, hi;
            lo[0] = A[0] * g0 * __builtin_amdgcn_rcpf(1.f + __expf(-g0)); lo[1] = A[1] * g1 * __builtin_amdgcn_rcpf(1.f + __expf(-g1));
            lo[2] = A[2] * g2 * __builtin_amdgcn_rcpf(1.f + __expf(-g2)); lo[3] = A[3] * g3 * __builtin_amdgcn_rcpf(1.f + __expf(-g3));
            hi[0] = B[0] * g4 * __builtin_amdgcn_rcpf(1.f + __expf(-g4)); hi[1] = B[1] * g5 * __builtin_amdgcn_rcpf(1.f + __expf(-g5));
            hi[2] = B[2] * g6 * __builtin_amdgcn_rcpf(1.f + __expf(-g6)); hi[3] = B[3] * g7 * __builtin_amdgcn_rcpf(1.f + __expf(-g7));
            st8(orow + 32 * dt + 16 * ap + 8 * hf, lo, hi);
        }
}

template <bool MASK>
DI void sb_math(const f32x16& s, int limh, int hf, float& carry, f32x16& pr) {
    f32x16 lg, n1;
#pragma unroll
    for (int i = 0; i < 16; ++i) {
        const float z = __builtin_amdgcn_fmed3f(s[i], -100.f, 100.f);
        const float l = flog2(1.f + fexp2(-z));
        if (MASK) { const bool vis = ((8 * (i >> 2) + (i & 3)) < limh); lg[i] = vis ? l : 1e30f; n1[i] = vis ? (l + z) : 0.f; }
        else { lg[i] = l; n1[i] = l + z; }
    }
    float gs[4], og[4];
#pragma unroll
    for (int a = 0; a < 4; ++a) { gs[a] = (n1[4 * a] + n1[4 * a + 1]) + (n1[4 * a + 2] + n1[4 * a + 3]); og[a] = xor32(gs[a], hf); }
    float run = carry;
#pragma unroll
    for (int a = 3; a >= 0; --a) {
        float t = run + (hf ? 0.f : og[a]);
        pr[4 * a + 3] = fexp2(-(lg[4 * a + 3] + t)); t += n1[4 * a + 3];
        pr[4 * a + 2] = fexp2(-(lg[4 * a + 2] + t)); t += n1[4 * a + 2];
        pr[4 * a + 1] = fexp2(-(lg[4 * a + 1] + t)); t += n1[4 * a + 1];
        pr[4 * a + 0] = fexp2(-(lg[4 * a + 0] + t));
        run += gs[a] + og[a];
    }
    carry = run;
}

template <int MODE>
DI void attn_item(const Params& p, LAS unsigned char* lds, int b, int h, int qb, bool metaq) {
    constexpr int DK = (MODE == 1) ? 96 : 64, KSTR = DK + 8, NKS = DK / 16;
    constexpr int KBYTES = 64 * KSTR * 2, VBYTES = 64 * VSTR * 2, BUF = KBYTES + VBYTES;
    unsigned char* ws = p.ws;
    const int tid = threadIdx.x, wid = __builtin_amdgcn_readfirstlane(tid >> 6), lane = tid & 63, ql = lane & 31, hf = lane >> 5;
    const int ldp = (MODE == 2) ? 2304 : 3072;
    const bf16_t* proj = (const bf16_t*)(ws + OFF_PROJ); const bf16_t* projm = (const bf16_t*)(ws + OFF_PROJ_META);
    const bf16_t *Kreal, *Kmeta, *Krreal = nullptr, *Krmeta = nullptr, *Vtreal, *Vtmeta; int ldk;
    if (MODE == 0) { Kreal = proj + (size_t)b * SEQ * 3072 + 512 + h * 64; Kmeta = projm + 512 + h * 64; ldk = 3072;
        Vtreal = (const bf16_t*)(ws + OFF_VSBT) + (size_t)(h * 64) * R + b * SEQ; Vtmeta = (const bf16_t*)(ws + OFF_VSBT_META) + h * 64 * 16; }
    else if (MODE == 1) { Kreal = (const bf16_t*)(ws + OFF_KM) + (size_t)b * SEQ * 512 + h * 64; Kmeta = (const bf16_t*)(ws + OFF_KM_META) + h * 64; ldk = 512;
        Krreal = proj + (size_t)b * SEQ * 3072 + 2432; Krmeta = projm + 2432;
        Vtreal = (const bf16_t*)(ws + OFF_VMT) + (size_t)(h * 64) * R + b * SEQ; Vtmeta = (const bf16_t*)(ws + OFF_VMT_META) + h * 64 * 16; }
    else { Kreal = proj + (size_t)b * SEQ * 2304 + 1024 + h * 64; Kmeta = projm + 1024 + h * 64; ldk = 2304;
        Vtreal = (const bf16_t*)(ws + OFF_VSBT) + (size_t)(128 + h * 64) * R + b * SEQ; Vtmeta = (const bf16_t*)(ws + OFF_VSBT_META) + (128 + h * 64) * 16; }
    const int head = (MODE == 2) ? h * 8 + wid : h;
    int qrow;
    bool wactive = true;
    if (MODE == 2) qrow = 32 * qb + ql;
    else if (metaq) { qrow = (ql < 16) ? ql : 15; wactive = (wid == 0); }
    else qrow = 256 * qb + 32 * wid + ql;
    const bf16_t* qptr;
    if (MODE == 0) qptr = metaq ? projm + (size_t)qrow * 3072 + h * 64 : proj + ((size_t)b * SEQ + qrow) * 3072 + h * 64;
    else if (MODE == 1) qptr = metaq ? (const bf16_t*)(ws + OFF_QM_META) + (size_t)qrow * 768 + h * 96 : (const bf16_t*)(ws + OFF_QM) + ((size_t)b * SEQ + qrow) * 768 + h * 96;
    else qptr = proj + ((size_t)b * SEQ + qrow) * 2304 + head * 64;
    bf16x8 qf[NKS];
#pragma unroll
    for (int ks = 0; ks < NKS; ++ks) qf[ks] = *(const bf16x8*)(qptr + 16 * ks + 8 * hf);
    int T, ntiles, t0 = 0;
    if (MODE == 2) { const int lo = 32 * qb - 127; t0 = (lo > 0 ? lo : 0) >> 6; T = (qb >> 1) - t0 + 1; ntiles = T + 1; }
    else { T = metaq ? 0 : 4 * (qb + 1); ntiles = T + 1; }
#define TILE_OF(j, ism, key0) do { if (MODE == 0) { ism = ((j) >= T); key0 = 64 * (T - 1 - (j)); } else if (MODE == 1) { ism = ((j) == 0); key0 = 64 * ((j) - 1); } else { ism = ((j) == 0); key0 = 64 * (t0 + (j) - 1); } } while (0)
    u32x4 kreg, krreg, vreg;
    krreg = (u32x4){0u, 0u, 0u, 0u};
#define ISSUE(j) do { bool ism_; int key0_; TILE_OF(j, ism_, key0_); \
        { const int row = tid >> 3, ch = tid & 7; const int rr = ism_ ? (row < 16 ? row : 15) : key0_ + row; kreg = *(const u32x4*)((ism_ ? Kmeta : Kreal) + (size_t)rr * ldk + ch * 8); } \
        if (MODE == 1) { if (tid < 256) { const int row = tid >> 2, ch = tid & 3; const int rr = ism_ ? (row < 16 ? row : 15) : key0_ + row; krreg = *(const u32x4*)((ism_ ? Krmeta : Krreal) + (size_t)rr * 3072 + ch * 8); } } \
        { const int d = tid >> 3, ch = tid & 7; \
          if (ism_) { vreg = (u32x4){0u, 0u, 0u, 0u}; if (ch < 2) vreg = *(const u32x4*)(Vtmeta + d * 16 + ch * 8); } \
          else vreg = *(const u32x4*)(Vtreal + (size_t)d * R + key0_ + ch * 8); } } while (0)
#define STASH(buf) do { LAS unsigned char* kb_ = lds + (buf) * BUF; LAS unsigned char* vb_ = kb_ + KBYTES; \
        *(LAS u32x4*)(kb_ + (tid >> 3) * (KSTR * 2) + (tid & 7) * 16) = kreg; \
        if (MODE == 1) { if (tid < 256) *(LAS u32x4*)(kb_ + (tid >> 2) * (KSTR * 2) + 128 + (tid & 3) * 16) = krreg; } \
        vt_store(vb_ + (tid >> 3) * (VSTR * 2), tid & 7, vreg); } while (0)

    f32x16 O[2];
#pragma unroll
    for (int i = 0; i < 16; ++i) { O[0][i] = 0.f; O[1][i] = 0.f; }
    float carry = 0.f;
    float mrun = 0.f, lpart = 0.f;
    bool sm_first = true;


    bool wdone = !wactive;
    LAS int* flags = (LAS int*)(lds + 65536);
    ISSUE(0); STASH(0); __syncthreads();
    for (int j = 0; j < ntiles; ++j) {
        if (j + 1 < ntiles) ISSUE(j + 1);
        bool ism; int key0; TILE_OF(j, ism, key0);
        LAS const unsigned char* kt = lds + (j & 1) * BUF; LAS const unsigned char* vt = kt + KBYTES;
        if (wactive && !wdone) {
            if (MODE == 0) {
#pragma unroll
                for (int sb = 1; sb >= 0; --sb) {
                    int lim; bool needmask = true;
                    if (ism) { if (sb == 1) continue; lim = metaq ? (ql < 16 ? ql : 16) : 16; }
                    else { const int rel = (key0 >> 5) + sb - (8 * qb + wid); if (rel > 0) continue; lim = (rel == 0) ? ql : 64; needmask = (rel == 0); }
                    const int limh = lim - 4 * hf;
                    bf16x8 kf[NKS], vf[2][2];
                    k_frags<NKS, KSTR>(kt, sb, ql, hf, kf);
                    __builtin_amdgcn_sched_barrier(0);
                    const f32x16 s = qk_mma<NKS>(kf, qf, splat16(0.f));
                    f32x16 pr;
                    if (needmask) sb_math<true>(s, limh, hf, carry, pr); else sb_math<false>(s, limh, hf, carry, pr);
                    v_frags<VSTR * 2>(vt, sb, ql, hf, vf);
                    pv_mma(vf, pr, O);
                }
            } else {
                f32x16 s[2]; bool have[2], needmask[2]; int hi[2];
#pragma unroll
                for (int sb = 0; sb < 2; ++sb) {
                    have[sb] = true; needmask[sb] = true;
                    if (ism) { if (sb == 1) have[sb] = false; hi[sb] = (metaq ? (ql + 1 < 16 ? ql + 1 : 16) : 16) - 4 * hf - 1; }
                    else { const int rel = (key0 >> 5) + sb - (8 * qb + wid); if (rel > 0) have[sb] = false; hi[sb] = ((rel == 0) ? ql + 1 : 64) - 4 * hf - 1; needmask[sb] = (rel == 0); }
                }
                if (have[0] || have[1]) {
                    bf16x8 kf[NKS], vf0[2][2], vf1[2][2];
                    if (have[0]) { k_frags<NKS, KSTR>(kt, 0, ql, hf, kf);
                        __builtin_amdgcn_sched_barrier(0);
                        s[0] = qk_mma<NKS>(kf, qf, splat16(-mrun)); }
                    if (have[1]) { k_frags<NKS, KSTR>(kt, 1, ql, hf, kf);
                        __builtin_amdgcn_sched_barrier(0);
                        s[1] = qk_mma<NKS>(kf, qf, splat16(-mrun)); }
                    if (have[0]) v_frags<VSTR * 2>(vt, 0, ql, hf, vf0);
                    if (have[1]) v_frags<VSTR * 2>(vt, 1, ql, hf, vf1);
                    __builtin_amdgcn_sched_barrier(0);
#pragma unroll
                    for (int sb = 0; sb < 2; ++sb) if (have[sb] && needmask[sb]) {
#pragma unroll
                        for (int i = 0; i < 16; ++i) { const int cst = 8 * (i >> 2) + (i & 3); s[sb][i] = (cst <= hi[sb]) ? s[sb][i] : -1e30f; }
                    }
                    softmax_update(s, have, sm_first, hf, mrun, lpart, O); sm_first = false;
                    if (have[0]) pv_mma(vf0, s[0], O);
                    if (have[1]) pv_mma(vf1, s[1], O);
                }
            }
        }
        if (MODE == 0) {
            if (!wdone) wdone = __all(carry > -SB_THRESH);
            if (lane == 0) flags[(j & 1) * 8 + wid] = wdone ? 1 : 0;
        }
        if (j + 1 < ntiles) STASH((j + 1) & 1);
        __syncthreads();
        if (MODE == 0) {
            int alld = 1;
#pragma unroll
            for (int w = 0; w < 8; ++w) alld &= flags[(j & 1) * 8 + w];
            if (alld) break;
        }
    }
#undef TILE_OF
#undef ISSUE
#undef STASH
    int qrow_e = qrow; asm volatile("" : "+v"(qrow_e));
    if (wactive && (!metaq || ql < 16)) {
        float inv = 1.f;
        if (MODE != 0) { const float l = lpart + xor32(lpart, hf); inv = 1.f / l; }
        const bf16_t* gptr; bf16_t* optr;
        if (MODE == 0) { gptr = metaq ? projm + (size_t)qrow_e * 3072 + 1536 + h * 64 : proj + ((size_t)b * SEQ + qrow_e) * 3072 + 1536 + h * 64;
            optr = metaq ? (bf16_t*)(ws + OFF_AO_META) + (size_t)qrow_e * 1024 + h * 64 : (bf16_t*)(ws + OFF_HN) + ((size_t)b * SEQ + qrow_e) * 1024 + h * 64; }
        else if (MODE == 1) { gptr = metaq ? projm + (size_t)qrow_e * 3072 + 2464 + h * 64 : proj + ((size_t)b * SEQ + qrow_e) * 3072 + 2464 + h * 64;
            optr = metaq ? (bf16_t*)(ws + OFF_AO_META) + (size_t)qrow_e * 1024 + 512 + h * 64 : (bf16_t*)(ws + OFF_HN) + ((size_t)b * SEQ + qrow_e) * 1024 + 512 + h * 64; }
        else { gptr = proj + ((size_t)b * SEQ + qrow_e) * 2304 + 1280 + head * 64; optr = (bf16_t*)(ws + OFF_HN) + ((size_t)b * SEQ + qrow_e) * 1024 + head * 64; }
        u32x4 gq4[4];
#pragma unroll
        for (int k = 0; k < 4; ++k) gq4[k] = *(const u32x4*)(gptr + 16 * k + 8 * hf);
        attn_store(O, inv, gq4, optr, hf);
    }
}

DI void attn0_phase(const Params& p, LAS unsigned char* lds) {
    const bool g256 = (gridDim.x == 256);
    for (int it = blockIdx.x; it < (g256 ? 2048 : 2048 + 16); it += gridDim.x) {
        if (it < 2048) {
            const int j = it >> 8, c = it & 255, b = c >> 4, h = (c & 15) >> 1, st = c & 1, type = j & 1, qi = j >> 1;
            const int sel = type ? st : 1 - st;
            const int qb = sel ? (qi == 0 ? 6 : qi == 1 ? 5 : qi == 2 ? 2 : 1) : (qi == 0 ? 7 : qi == 1 ? 4 : qi == 2 ? 3 : 0);
            if (type == 0) attn_item<0>(p, lds, b, h, qb, false); else attn_item<1>(p, lds, b, h, qb, false);
        } else { const int hh = it - 2048; if (hh < 8) attn_item<0>(p, lds, 0, hh, 0, true); else attn_item<1>(p, lds, 0, hh - 8, 0, true); }
    }
    if (g256 && (blockIdx.x & 1) && blockIdx.x < 32) { const int hh = blockIdx.x >> 1; if (hh < 8) attn_item<0>(p, lds, 0, hh, 0, true); else attn_item<1>(p, lds, 0, hh - 8, 0, true); }
}
struct SwaRegs { u32x4 kr[4], vr[4], mr; };
DI void swa_load(const Params& p, int b, int kvh, int I, SwaRegs& g) {
    unsigned char* ws = p.ws; const int tid = threadIdx.x;
    const bf16_t* proj = (const bf16_t*)(ws + OFF_PROJ); const bf16_t* projm = (const bf16_t*)(ws + OFF_PROJ_META);
    const int kb = 128 * I - 128;
    const bf16_t* Kreal = proj + (size_t)b * SEQ * 2304 + 1024 + kvh * 64; const bf16_t* Kmeta = projm + 1024 + kvh * 64;
    const bf16_t* Vtreal = (const bf16_t*)(ws + OFF_VSBT) + (size_t)(128 + kvh * 64) * R + b * SEQ; const bf16_t* Vtmeta = (const bf16_t*)(ws + OFF_VSBT_META) + (128 + kvh * 64) * 16;
    g.mr = (u32x4){0u, 0u, 0u, 0u};
#pragma unroll
    for (int i = 0; i < 4; ++i) { const int c = tid + 512 * i, row = c >> 3, ch = c & 7, key = kb + row;
        g.kr[i] = (u32x4){0u, 0u, 0u, 0u}; if (key >= 0) g.kr[i] = *(const u32x4*)(Kreal + (size_t)key * 2304 + ch * 8); }
#pragma unroll
    for (int i = 0; i < 4; ++i) { const int c = tid + 512 * i, d = c >> 5, ch = c & 31, key = kb + 8 * ch;
        g.vr[i] = (u32x4){0u, 0u, 0u, 0u}; if (key >= 0) g.vr[i] = *(const u32x4*)(Vtreal + (size_t)d * R + key); }
    if (tid < 128) { const int row = tid >> 3, ch = tid & 7; g.mr = *(const u32x4*)(Kmeta + row * 2304 + ch * 8); }
    else if (tid < 256) { const int t = tid - 128, d = t >> 1, ch = t & 1; g.mr = *(const u32x4*)(Vtmeta + d * 16 + ch * 8); }
}
DI void swa_stash(LAS unsigned char* lds, const SwaRegs& g) {
    constexpr int KSB = 144, VSB = 592, KBYTES = 288 * KSB;
    const int tid = threadIdx.x; LAS unsigned char* kbuf = lds; LAS unsigned char* vbuf = lds + KBYTES;
#pragma unroll
    for (int i = 0; i < 4; ++i) { const int c = tid + 512 * i; *(LAS u32x4*)(kbuf + (c >> 3) * KSB + (c & 7) * 16) = g.kr[i]; vt_store(vbuf + (c >> 5) * VSB, c & 31, g.vr[i]); }
    if (tid < 128) *(LAS u32x4*)(kbuf + (256 + (tid >> 3)) * KSB + (tid & 7) * 16) = g.mr;
    else if (tid < 256) { const int t = tid - 128; vt_store(vbuf + (t >> 1) * VSB, 32 + (t & 1), g.mr); }
    else if (tid < 384) { const int t = tid - 256; *(LAS u32x4*)(vbuf + (t >> 1) * VSB + 544 + (t & 1) * 16) = (u32x4){0u, 0u, 0u, 0u}; }
}
DI void swa_compute(const Params& p, LAS unsigned char* lds, int b, int kvh, int I) {
    constexpr int KSB = 144, VSB = 592, KBYTES = 288 * KSB;
    unsigned char* ws = p.ws;
    const int tid = threadIdx.x, wid = __builtin_amdgcn_readfirstlane(tid >> 6), lane = tid & 63, ql = lane & 31, hf = lane >> 5;
    const bf16_t* proj = (const bf16_t*)(ws + OFF_PROJ);
    LAS unsigned char* kbuf = lds; LAS unsigned char* vbuf = lds + KBYTES;
    const int head = kvh * 8 + wid;
    const float slope2 = fexp2(-0.5f * (float)(head + 1)) * LOG2E, sink2 = p.od_sinks[head] * LOG2E;
    const bf16_t* rowp = proj + ((size_t)b * SEQ + 128 * I + ql) * 2304;
    bf16x8 qf[4];
#pragma unroll
    for (int ks = 0; ks < 4; ++ks) qf[ks] = *(const bf16x8*)(rowp + head * 64 + 16 * ks + 8 * hf);
#pragma unroll 1
    for (int qs = 0; qs < 4; ++qs) {
        const int qrow = 32 * (4 * I + qs) + ql;
        const bf16_t* nrow = rowp + (size_t)(qs < 3 ? 32 * (qs + 1) : 32 * qs) * 2304;
        bf16x8 qn[4];
#pragma unroll
        for (int ks = 0; ks < 4; ++ks) qn[ks] = *(const bf16x8*)(nrow + head * 64 + 16 * ks + 8 * hf);
        const bf16_t* gptr = rowp + (size_t)(32 * qs) * 2304 + 1280 + head * 64;
        u32x4 gq4[4];
#pragma unroll
        for (int k = 0; k < 4; ++k) gq4[k] = *(const u32x4*)(gptr + 16 * k + 8 * hf);
        f32x16 O[2];
#pragma unroll
        for (int i = 0; i < 16; ++i) { O[0][i] = 0.f; O[1][i] = 0.f; }
        float mrun = sink2, lpart = (hf == 0) ? 1.f : 0.f;
#pragma unroll 1
        for (int pr_ = 0; pr_ < 3; ++pr_) {
            int subs[2]; subs[0] = (pr_ == 0) ? 8 : qs + 2 * pr_ - 1; subs[1] = qs + 2 * pr_;
            f32x16 s[2]; bool have[2]; int lo_[2], hi_[2]; float nb_[2];
#pragma unroll
            for (int t = 0; t < 2; ++t) {
                const int sub = subs[t]; int lo = -1000, hi = 1000; float nb;
                if (sub == 8) { have[t] = true; hi = 15 - 4 * hf; nb = -slope2 * (float)(16 + qrow - 4 * hf); }
                else { have[t] = !(I == 0 && sub < 4); const int k = qs + 4 - sub; const int Dl = 32 * k + ql; nb = -slope2 * (float)(Dl - 4 * hf);
                    if (k == 0) hi = Dl - 4 * hf; if (k == 4) lo = Dl - 127 - 4 * hf; }
                lo_[t] = lo; hi_[t] = hi; nb_[t] = nb;
            }
            bf16x8 kf0[4], kf1[4], vf0[2][2], vf1[2][2];
            if (have[0]) k_frags<4, 72>(kbuf, subs[0], ql, hf, kf0);
            __builtin_amdgcn_sched_barrier(0);
            if (have[0]) { f32x16 ini; const float c0 = nb_[0] - mrun;
#pragma unroll
                for (int i = 0; i < 16; ++i) ini[i] = slope2 * (float)(8 * (i >> 2) + (i & 3)) + c0;
                s[0] = qk_mma<4>(kf0, qf, ini); }
            if (have[1]) k_frags<4, 72>(kbuf, subs[1], ql, hf, kf1);
            __builtin_amdgcn_sched_barrier(0);
            if (have[1]) { f32x16 ini; const float c0 = nb_[1] - mrun;
#pragma unroll
                for (int i = 0; i < 16; ++i) ini[i] = slope2 * (float)(8 * (i >> 2) + (i & 3)) + c0;
                s[1] = qk_mma<4>(kf1, qf, ini); }
#pragma unroll
            for (int t = 0; t < 2; ++t) {
                if (have[t]) {
                    if (hi_[t] < 1000) {
#pragma unroll
                        for (int i = 0; i < 16; ++i) { const int cst = 8 * (i >> 2) + (i & 3); s[t][i] = (cst <= hi_[t]) ? s[t][i] : -1e30f; }
                    }
                    if (lo_[t] > -1000) {
#pragma unroll
                        for (int i = 0; i < 16; ++i) { const int cst = 8 * (i >> 2) + (i & 3); s[t][i] = (cst >= lo_[t]) ? s[t][i] : -1e30f; }
                    }
                }
            }
            softmax_update(s, have, false, hf, mrun, lpart, O);
            if (have[0]) { v_frags<VSB>(vbuf, subs[0], ql, hf, vf0); pv_mma(vf0, s[0], O); }
            if (have[1]) { v_frags<VSB>(vbuf, subs[1], ql, hf, vf1); pv_mma(vf1, s[1], O); }
        }
        const float inv = 1.f / (lpart + xor32(lpart, hf));
        bf16_t* optr = (bf16_t*)(ws + OFF_HN) + ((size_t)b * SEQ + qrow) * 1024 + head * 64;
        attn_store(O, inv, gq4, optr, hf);
#pragma unroll
        for (int ks = 0; ks < 4; ++ks) qf[ks] = qn[ks];
    }
}
DI void attn1_phase(const Params& p, LAS unsigned char* lds) {
    for (int it = blockIdx.x; it < 512; it += gridDim.x) {
        { SwaRegs g; swa_load(p, it >> 5, (it >> 4) & 1, it & 15, g);
          __syncthreads();
          swa_stash(lds, g); }
        __syncthreads();
        swa_compute(p, lds, it >> 5, (it >> 4) & 1, it & 15);
    }
}

#define XB_TMO      128
#define XB_XCNT(j)  (256  + 64 * (j))
#define XB_XSUB(j)  (1280 + 64 * (j))
#define XB_XGEN(j)  (2304 + 64 * (j))
#define XB_TOP      3328
#define XB_TOPGEN   3392
#define XCD_BAR_WORDS 3456
#define XB_SPIN_CAP (1u << 18)
DI unsigned xb_ld(unsigned* p)              { return __hip_atomic_load(p, __ATOMIC_RELAXED, __HIP_MEMORY_SCOPE_AGENT); }
DI unsigned xb_add(unsigned* p, unsigned v) { return __hip_atomic_fetch_add(p, v, __ATOMIC_RELAXED, __HIP_MEMORY_SCOPE_AGENT); }
DI unsigned xb_xcc_id() { return (unsigned)__builtin_amdgcn_s_getreg((3 << 11) | 20) & 0xFu; }
#define XB_SPIN(cond, bar) do { unsigned _sp = 0; while (cond) { __builtin_amdgcn_s_sleep(1); \
    if ((++_sp & 255u) == 0u) { if (xb_ld(&(bar)[XB_TMO])) break; if (_sp > XB_SPIN_CAP) { atomicAdd(&(bar)[XB_TMO], 1u); break; } } } } while (0)
struct XcdBarrier { unsigned* bar; unsigned x; volatile LAS unsigned* st; };
DI XcdBarrier xcd_barrier_post(unsigned* bar, volatile LAS unsigned* st) {
    XcdBarrier b; b.bar = bar; b.x = xb_xcc_id(); b.st = st;
    if (threadIdx.x == 0) (void)xb_add(&bar[XB_XCNT(b.x)], 1u);
    return b;
}
DI void xcd_barrier_complete(unsigned* bar, unsigned x, unsigned& nloc, unsigned& nx) {
    const unsigned G = gridDim.x * gridDim.y * gridDim.z;
    unsigned sum, cnt, mine, sp = 0u;
    for (;;) {
        sum = 0u; cnt = 0u; mine = 0u;
#pragma unroll
        for (unsigned j = 0; j < 16; ++j) { const unsigned c = xb_ld(&bar[XB_XCNT(j)]); sum += c; cnt += (c > 0u) ? 1u : 0u; mine = (j == x) ? c : mine; }
        if (sum == G) break;
        __builtin_amdgcn_s_sleep(1);
        if ((++sp & 255u) == 0u) { if (xb_ld(&bar[XB_TMO])) break; if (sp > XB_SPIN_CAP) { atomicAdd(&bar[XB_TMO], 1u); break; } }
    }
    nloc = mine > 0u ? mine : 1u; nx = cnt > 0u ? cnt : 1u;
}
DI void xcd_barrier(const XcdBarrier& b) {
    asm volatile("s_waitcnt vmcnt(0)" ::: "memory");
    __syncthreads();
    if (threadIdx.x == 0) {
        unsigned* bar = b.bar;
        __builtin_amdgcn_s_waitcnt(0);
        unsigned nloc = b.st[0], nx = b.st[1];
        if (nloc == 0u) { xcd_barrier_complete(bar, b.x, nloc, nx); b.st[0] = nloc; b.st[1] = nx; }
        const unsigned old = xb_add(&bar[XB_XSUB(b.x)], 1u);
        const unsigned gen = old / nloc;
        if (old + 1u == (gen + 1u) * nloc) {
            __builtin_amdgcn_fence(__ATOMIC_RELEASE, "agent");
            asm volatile("s_waitcnt vmcnt(0)" ::: "memory");
            const unsigned og = xb_add(&bar[XB_TOP], 1u);
            const unsigned tg = og / nx;
            if (og + 1u == (tg + 1u) * nx) xb_add(&bar[XB_TOPGEN], 1u);
            else XB_SPIN(xb_ld(&bar[XB_TOPGEN]) == tg, bar);
            __builtin_amdgcn_fence(__ATOMIC_ACQUIRE, "agent");
            xb_add(&bar[XB_XGEN(b.x)], 1u);
            asm volatile("s_waitcnt vmcnt(0)" ::: "memory");
        } else {
            XB_SPIN(xb_ld(&bar[XB_XGEN(b.x)]) == gen, bar);
            __builtin_amdgcn_fence(__ATOMIC_ACQUIRE, "agent");
            asm volatile("s_waitcnt vmcnt(0)" ::: "memory");
        }
    }
    __syncthreads();
}

template <int PH> DI void run_phase(const Params& p, LAS unsigned char* lds) {
    const int tid = threadIdx.x, wid = tid >> 6, lane = tid & 63;
    if (PH == 0) prep_phase(p, lds);
    else if (PH == 1) { gemm_phase<1>(p, lds); meta_phase<1>(p, lds); }
    else if (PH == 2) { gemm_phase<2>(p, lds); meta_phase<2>(p, lds);
        if (gridDim.x == 256) { if (blockIdx.x >= 128) weight_jobs(p, lds, WJ_EARLY, WJ_ALL, (blockIdx.x - 128) * 8 + wid, 128 * 8); }
        else weight_jobs(p, lds, WJ_EARLY, WJ_ALL, blockIdx.x * 8 + wid, gridDim.x * 8); }
    else if (PH == 3) { if (wid >= 4) __builtin_amdgcn_s_setprio(1); attn0_phase(p, lds); __builtin_amdgcn_s_setprio(0); }
    else if (PH == 4) { gemm_phase<4>(p, lds); meta_phase<4>(p, lds); }
    else if (PH == 5) {
        const int gw = blockIdx.x * 8 + wid, ngw = gridDim.x * 8;
        for (int row = gw; row < R; row += 2 * ngw) { const int r1 = row + ngw; const bool two = r1 < R;
            norm_rows_bf16(p.x, (const bf16_t*)(p.ws + OFF_D1), (size_t)row, (size_t)(two ? r1 : row), two, p.norm_g + 1024, (bf16_t*)(p.ws + OFF_HN), lane); }
        for (int row = gw; row < NMETA; row += ngw) norm_rows_bf16((const float*)(p.ws + OFF_H1_META), nullptr, (size_t)row, (size_t)row, false, p.norm_g + 1024, (bf16_t*)(p.ws + OFF_HN_META), lane);
    }
    else if (PH == 6) { gemm_phase<6>(p, lds); meta_phase<6>(p, lds); }
    else if (PH == 7) { if (wid >= 4) __builtin_amdgcn_s_setprio(1); attn1_phase(p, lds); __builtin_amdgcn_s_setprio(0); }
    else if (PH == 8) gemm_phase<8>(p, lds);
    else if (PH == 9) {
        const int gw = blockIdx.x * 8 + wid, ngw = gridDim.x * 8;
        for (int row = gw; row < R; row += 2 * ngw) { const int r1 = row + ngw; const bool two = r1 < R;
            norm_rows_f32(p.x, (const bf16_t*)(p.ws + OFF_D1), (const bf16_t*)(p.ws + OFF_D2), (size_t)row, (size_t)(two ? r1 : row), two, p.final_g, p.out, lane); }
    }
}

__global__ void __launch_bounds__(512, 2) mk_fwd(Params p) {
    extern __shared__ __attribute__((aligned(16))) unsigned char shm[];
    LAS unsigned char* lds = (LAS unsigned char*)shm;
    cg::grid_group grid = cg::this_grid();
    volatile LAS unsigned* st = (volatile LAS unsigned*)(lds + 131072);
    if (threadIdx.x == 0) { st[0] = 0u; st[1] = 0u; st[2] = 0u; st[3] = 0u; }
    __syncthreads();
    const XcdBarrier xb = xcd_barrier_post((unsigned*)(p.ws + OFF_BAR), st);
#define PHASE(n) do { if (p.ph_lo <= n && n < p.ph_hi) { run_phase<n>(p, lds); if (n + 1 < p.ph_hi) { if (p.ph_hi > 10) grid.sync(); else xcd_barrier(xb); } } } while (0)
    PHASE(0); PHASE(1); PHASE(2); PHASE(3); PHASE(4); PHASE(5); PHASE(6); PHASE(7); PHASE(8); PHASE(9);
}

extern "C" void kernel_launch(void* const* d_in, const int* in_sizes, int n_in, void* d_out, int out_size, void* d_ws, size_t ws_size, hipStream_t stream) {
    static int grid_blocks = 0;
    if (grid_blocks == 0) {
        if (n_in != 13 || ws_size < WS_END) { fprintf(stderr, "kernel_launch: unexpected inputs (n_in %d, ws %zu, need %zu)\n", n_in, ws_size, (size_t)WS_END); grid_blocks = -1; return; }
        int dev = 0, cus = 0, per_cu = 0;
        hipGetDevice(&dev);
        hipDeviceGetAttribute(&cus, hipDeviceAttributeMultiprocessorCount, dev);
        if (hipFuncSetAttribute((const void*)mk_fwd, hipFuncAttributeMaxDynamicSharedMemorySize, LDS_BYTES) != hipSuccess) { fprintf(stderr, "kernel_launch: hipFuncSetAttribute failed\n"); grid_blocks = -1; return; }
        if (hipOccupancyMaxActiveBlocksPerMultiprocessor(&per_cu, (const void*)mk_fwd, 512, LDS_BYTES) != hipSuccess || per_cu < 1) per_cu = 1;
        (void)hipGetLastError();
        grid_blocks = cus * per_cu;
    }
    if (grid_blocks < 0) return;
    Params p{};
    p.x = (const float*)d_in[0]; p.meta = (const float*)d_in[1]; p.norm_g = (const float*)d_in[2]; p.final_g = (const float*)d_in[3];
    p.ev_w_in = (const float*)d_in[4]; p.ev_qg = (const float*)d_in[5]; p.ev_kvg = (const float*)d_in[6]; p.ev_w_uq = (const float*)d_in[7];
    p.ev_w_ukv = (const float*)d_in[8]; p.ev_w_out = (const float*)d_in[9]; p.od_w_in = (const float*)d_in[10]; p.od_sinks = (const float*)d_in[11];
    p.od_w_out = (const float*)d_in[12];
    p.out = (float*)d_out; p.ws = (unsigned char*)d_ws;
    p.ph_lo = 0; p.ph_hi = 10;
    if (hipMemsetAsync((unsigned char*)d_ws + OFF_BAR, 0, BAR_BYTES, stream) != hipSuccess) { fprintf(stderr, "kernel_launch: memset of the barrier words failed\n"); return; }
    void* args[] = {&p};
    hipError_t e = hipLaunchCooperativeKernel((const void*)mk_fwd, dim3(grid_blocks), dim3(512), args, LDS_BYTES, stream);
    if (e != hipSuccess) fprintf(stderr, "cooperative launch failed: %s (grid %d)\n", hipGetErrorString(e), grid_blocks);
}
```
